# Optimizing an MI355X kernel written in HIP

```python
import jax, jax.numpy as jnp
from jax import lax
import numpy as np

D_MODEL = 1024
BATCH = 2
SEQ = 16384
DEPTH = 1

GLA_HEADS = 4
GLA_DK = D_MODEL // 2 // GLA_HEADS
GLA_DV = D_MODEL // GLA_HEADS
GLA_RANK = 16
GLA_GATE_NORM = 16.0
GDN_HEADS = 8
GDN_DK = D_MODEL // GDN_HEADS
GDN_DV = D_MODEL // GDN_HEADS
CONV_K = 4
CHUNK = 64
D_FF = 4 * D_MODEL
EPS = 1e-6

GLA_QK = GLA_HEADS * GLA_DK
GLA_V = GLA_HEADS * GLA_DV
GDN_QK = GDN_HEADS * GDN_DK
GDN_V = GDN_HEADS * GDN_DV
GDN_CONV_DIM = 2 * GDN_QK + GDN_V
IN_WIDTHS = (GLA_QK, GLA_QK, GLA_V, GLA_V, GLA_RANK,
             GDN_CONV_DIM, GDN_V, GDN_HEADS, GDN_HEADS,
             D_MODEL, D_MODEL)
IN_DIM = 2 * GLA_QK + 2 * GLA_V + GLA_RANK + GDN_CONV_DIM + GDN_V + 2 * GDN_HEADS + 2 * D_MODEL

kernel_name = 'hybrid_gla_gdn_gated_merge_block'


def rms_norm(x, w):
    xf = x.astype(jnp.float32)
    y = xf * lax.rsqrt(jnp.mean(xf * xf, axis=-1, keepdims=True) + EPS)
    return (y * w.astype(jnp.float32)).astype(x.dtype)


def l2_norm(x):
    xf = x.astype(jnp.float32)
    return (xf * lax.rsqrt(jnp.sum(xf * xf, axis=-1, keepdims=True) + EPS)).astype(x.dtype)


def causal_short_conv(x, w):
    s = x.shape[1]
    k = w.shape[0]
    xp = jnp.pad(x, ((0, 0), (k - 1, 0), (0, 0)))
    y = xp[:, 0:s] * w[0]
    for j in range(1, k):
        y = y + xp[:, j:j + s] * w[j]
    return y


def to_chunks(t):
    b, s, h = t.shape[:3]
    t = t.reshape((b, s // CHUNK, CHUNK, h) + t.shape[3:])
    return jnp.moveaxis(t, 3, 1)


def from_chunks(t):
    b, h, n, c, d = t.shape
    return jnp.transpose(t, (0, 2, 3, 1, 4)).reshape(b, n * c, h, d)


def gla_chunked(q, k, v, gk):
    out_dtype = v.dtype
    dk = q.shape[-1]
    q = to_chunks(q.astype(jnp.float32)) * (dk ** -0.5)
    k = to_chunks(k.astype(jnp.float32))
    v = to_chunks(v.astype(jnp.float32))
    b = jnp.cumsum(to_chunks(gk.astype(jnp.float32)), axis=3)
    b_last = b[:, :, :, -1:, :]
    q_dec = q * jnp.exp(b)
    k_inv = k * jnp.exp(-b)
    causal = jnp.tril(jnp.ones((CHUNK, CHUNK), dtype=bool))
    att = jnp.einsum('bhnid,bhnjd->bhnij', q_dec, k_inv)
    att = jnp.where(causal, att, 0.0)
    o_intra = jnp.einsum('bhnij,bhnjv->bhniv', att, v)
    k_state = k * jnp.exp(b_last - b)
    dec = jnp.exp(b_last[:, :, :, 0, :])

    def step(state, inp):
        qd, ks, vv, dc = inp
        o = jnp.einsum('bhcd,bhdv->bhcv', qd, state)
        state = dc[..., None] * state + jnp.einsum('bhcd,bhcv->bhdv', ks, vv)
        return state, o

    bsz, h = q.shape[0], q.shape[1]
    s0 = jnp.zeros((bsz, h, dk, v.shape[-1]), jnp.float32)
    xs = (jnp.moveaxis(q_dec, 2, 0), jnp.moveaxis(k_state, 2, 0),
          jnp.moveaxis(v, 2, 0), jnp.moveaxis(dec, 2, 0))
    _, o_inter = lax.scan(step, s0, xs)
    o = o_intra + jnp.moveaxis(o_inter, 0, 2)
    return from_chunks(o).astype(out_dtype)


def gated_delta_chunked(q, k, v, beta, g):
    out_dtype = v.dtype
    dk = q.shape[-1]
    q = to_chunks(q.astype(jnp.float32)) * (dk ** -0.5)
    k = to_chunks(k.astype(jnp.float32))
    v = to_chunks(v.astype(jnp.float32))
    beta = to_chunks(beta.astype(jnp.float32))
    gc = jnp.cumsum(to_chunks(g.astype(jnp.float32)), axis=-1)
    causal = jnp.tril(jnp.ones((CHUNK, CHUNK), dtype=bool))
    strict = jnp.tril(jnp.ones((CHUNK, CHUNK), dtype=bool), k=-1)
    diff = gc[..., :, None] - gc[..., None, :]
    decay_mat = jnp.exp(jnp.where(causal, diff, -jnp.inf))
    kb = k * beta[..., None]
    a_mat = jnp.where(strict, jnp.einsum('bhnid,bhnjd->bhnij', kb, k) * decay_mat, 0.0)
    eye = jnp.eye(CHUNK, dtype=jnp.float32)
    rhs = jnp.concatenate([v * beta[..., None], kb * jnp.exp(gc)[..., None]], axis=-1)
    sol = lax.linalg.triangular_solve(a_mat + eye, rhs, left_side=True, lower=True)
    dv = v.shape[-1]
    u = sol[..., :dv]
    w = sol[..., dv:]
    att = jnp.einsum('bhnid,bhnjd->bhnij', q, k) * decay_mat
    q_dec = q * jnp.exp(gc)[..., None]
    g_last = gc[..., -1]
    k_state = k * jnp.exp(g_last[..., None] - gc)[..., None]
    dec = jnp.exp(g_last)

    def step(state, inp):
        qd, at, uu, ww, ks, dc = inp
        v_new = uu - jnp.einsum('bhcd,bhdv->bhcv', ww, state)
        o = jnp.einsum('bhcd,bhdv->bhcv', qd, state) + jnp.einsum('bhij,bhjv->bhiv', at, v_new)
        state = dc[..., None, None] * state + jnp.einsum('bhcd,bhcv->bhdv', ks, v_new)
        return state, o

    bsz, h = q.shape[0], q.shape[1]
    s0 = jnp.zeros((bsz, h, dk, dv), jnp.float32)
    xs = tuple(jnp.moveaxis(t, 2, 0) for t in (q_dec, att, u, w, k_state, dec))
    _, o = lax.scan(step, s0, xs)
    return from_chunks(jnp.moveaxis(o, 0, 2)).astype(out_dtype)


def hybrid_layer(x, c, ada_w, ada_b, pre_mix_w, post_mix_w, pre_mlp_w, post_mlp_w,
                 w_in, gla_w_lr, gla_b_lr, gla_onorm_w, gdn_conv_w, gdn_a_log, gdn_dt_bias,
                 gdn_onorm_w, w_branch_gla, w_branch_gdn, w_out, mlp_w1, mlp_w2):
    bsz, s, d = x.shape
    mod = jax.nn.silu(c) @ ada_w + ada_b
    shift1, scale1, gate1, shift2, scale2, gate2 = [m[:, None, :] for m in jnp.split(mod, 6, axis=-1)]

    h = rms_norm(x, pre_mix_w) * (1.0 + scale1) + shift1
    proj = h @ w_in
    idx = [int(i) for i in np.cumsum(np.array(IN_WIDTHS))[:-1]]
    (a_q, a_k, a_v, a_g, a_lr, d_qkv, d_g, d_beta, d_a, m_a, m_d) = jnp.split(proj, idx, axis=-1)

    a_gk = jax.nn.log_sigmoid(a_lr @ gla_w_lr + gla_b_lr) / GLA_GATE_NORM
    o_a = gla_chunked(a_q.reshape(bsz, s, GLA_HEADS, GLA_DK),
                      a_k.reshape(bsz, s, GLA_HEADS, GLA_DK),
                      a_v.reshape(bsz, s, GLA_HEADS, GLA_DV),
                      a_gk.reshape(bsz, s, GLA_HEADS, GLA_DK))
    o_a = rms_norm(o_a, gla_onorm_w) * jax.nn.silu(a_g.reshape(bsz, s, GLA_HEADS, GLA_DV))
    y_a = o_a.reshape(bsz, s, GLA_V) @ w_branch_gla

    d_qkv = jax.nn.silu(causal_short_conv(d_qkv, gdn_conv_w))
    d_q, d_k, d_v = jnp.split(d_qkv, [GDN_QK, 2 * GDN_QK], axis=-1)
    d_q = l2_norm(d_q.reshape(bsz, s, GDN_HEADS, GDN_DK))
    d_k = l2_norm(d_k.reshape(bsz, s, GDN_HEADS, GDN_DK))
    beta = jax.nn.sigmoid(d_beta)
    g = -jnp.exp(gdn_a_log) * jax.nn.softplus(d_a + gdn_dt_bias)
    o_d = gated_delta_chunked(d_q, d_k, d_v.reshape(bsz, s, GDN_HEADS, GDN_DV), beta, g)
    o_d = rms_norm(o_d, gdn_onorm_w) * jax.nn.silu(d_g.reshape(bsz, s, GDN_HEADS, GDN_DV))
    y_d = o_d.reshape(bsz, s, GDN_V) @ w_branch_gdn

    merged = jax.nn.sigmoid(m_a) * y_a + jax.nn.sigmoid(m_d) * y_d
    x = x + gate1 * rms_norm(merged @ w_out, post_mix_w)

    h2 = rms_norm(x, pre_mlp_w) * (1.0 + scale2) + shift2
    y = jnp.square(jax.nn.relu(h2 @ mlp_w1)) @ mlp_w2
    x = x + gate2 * rms_norm(y, post_mlp_w)
    return x


def setup_inputs(seed: int = 0) -> dict:
    key = jax.random.key(seed)
    ks = jax.random.split(key, 24)
    L, D = DEPTH, D_MODEL
    f32 = jnp.float32

    def nrm(k, shape, scale):
        return jax.random.normal(k, shape, f32) * scale

    def gain(k, n):
        return 1.0 + 0.02 * jax.random.normal(k, (L, n), f32)

    dt = jnp.exp(jax.random.uniform(ks[13], (L, GDN_HEADS), f32, np.log(1e-3), np.log(1e-1)))
    return {
        'x': jax.random.normal(ks[0], (BATCH, SEQ, D), f32),
        'c': jax.random.normal(ks[1], (BATCH, D), f32),
        'ada_w': nrm(ks[2], (L, D, 6 * D), D ** -0.5),
        'ada_b': nrm(ks[3], (L, 6 * D), 0.02),
        'pre_mix_w': gain(ks[4], D),
        'post_mix_w': gain(ks[5], D),
        'pre_mlp_w': gain(ks[6], D),
        'post_mlp_w': gain(ks[7], D),
        'w_in': nrm(ks[8], (L, D, IN_DIM), D ** -0.5),
        'gla_w_lr': nrm(ks[9], (L, GLA_RANK, GLA_QK), GLA_RANK ** -0.5),
        'gla_b_lr': nrm(ks[10], (L, GLA_QK), 0.1),
        'gla_onorm_w': gain(ks[11], GLA_DV),
        'gdn_conv_w': nrm(ks[12], (L, CONV_K, GDN_CONV_DIM), CONV_K ** -0.5),
        'gdn_a_log': jnp.log(jax.random.uniform(ks[14], (L, GDN_HEADS), f32, 1.0, 16.0)),
        'gdn_dt_bias': dt + jnp.log(-jnp.expm1(-dt)),
        'gdn_onorm_w': gain(ks[15], GDN_DV),
        'w_branch_gla': nrm(ks[16], (L, GLA_V, D), GLA_V ** -0.5),
        'w_branch_gdn': nrm(ks[17], (L, GDN_V, D), GDN_V ** -0.5),
        'w_out': nrm(ks[18], (L, D, D), D ** -0.5),
        'mlp_w1': nrm(ks[19], (L, D, D_FF), D ** -0.5),
        'mlp_w2': nrm(ks[20], (L, D_FF, D), D_FF ** -0.5),
    }


def reference(x, c, ada_w, ada_b, pre_mix_w, post_mix_w, pre_mlp_w, post_mlp_w,
              w_in, gla_w_lr, gla_b_lr, gla_onorm_w, gdn_conv_w, gdn_a_log, gdn_dt_bias,
              gdn_onorm_w, w_branch_gla, w_branch_gdn, w_out, mlp_w1, mlp_w2):
    for l in range(DEPTH):
        x = hybrid_layer(x, c, ada_w[l], ada_b[l], pre_mix_w[l], post_mix_w[l], pre_mlp_w[l],
                         post_mlp_w[l], w_in[l], gla_w_lr[l], gla_b_lr[l], gla_onorm_w[l],
                         gdn_conv_w[l], gdn_a_log[l], gdn_dt_bias[l], gdn_onorm_w[l],
                         w_branch_gla[l], w_branch_gdn[l], w_out[l], mlp_w1[l], mlp_w2[l])
    return x
```

```cpp
#include <hip/hip_runtime.h>
#include <hip/hip_cooperative_groups.h>
#include <cstdio>
#include <cstdint>
namespace cg = cooperative_groups;
namespace pg8 {
#define PG8_LAS __attribute__((address_space(3)))
typedef unsigned short bf16_t;
typedef short bf16x8 __attribute__((ext_vector_type(8)));
typedef float f32x4 __attribute__((ext_vector_type(4)));
typedef unsigned u32x4 __attribute__((ext_vector_type(4)));
constexpr int BM = 256, BK = 64, HALF = 128, HTB = HALF * BK * 2  , STAGE_BYTES = 8 * HTB, NXCD = 8, WGM = 8;

__host__ __device__ __forceinline__ int lds_byte(int r, int c) { const int st = (r >> 4) * 2 + (c >> 5), rr = r & 15, cc = c & 31, ob = rr * 64 + cc * 2; return st * 1024 + (ob ^ (((ob >> 9) & 1) << 5)); }
__host__ __device__ __forceinline__ void stage_rc(int b, int& R, int& C) { const int st = b / 1024, sb = b % 1024, swz = sb ^ (((sb >> 9) & 1) << 5); R = (st >> 1) * 16 + swz / 64; C = (st & 1) * 32 + (swz % 64) / 2; }
__host__ __device__ __forceinline__ int perm32(int rho) { const int n = rho >> 4, i = rho & 15; return 8 * (i >> 2) + 4 * n + (i & 3); }

struct Unit { int pm, pn; };
struct Gemm { const bf16_t* A; const bf16_t* Bt; int M, N, K; };

struct StaticOrder {
    int nM, nN, nwg, G, c;
    __host__ __device__ void init(int M, int N, int G_, int c_) { nM = M / BM; nN = N / BM; nwg = nM * nN; G = G_; c = c_; }
    __host__ __device__ bool next(int i, Unit& u) const {
        const long L = (long)i * G + c; if (L >= nwg) return false;
        int wgid = (int)L; { const int q = nwg / NXCD, r = nwg % NXCD, xcd = wgid % NXCD, off = wgid / NXCD; wgid = (xcd < r ? xcd * (q + 1) : r * (q + 1) + (xcd - r) * q) + off; }
        const int nig = WGM * nN, gid = wgid / nig, fm = gid * WGM, gsz = (nM - fm) < WGM ? (nM - fm) : WGM;
        u.pm = fm + ((wgid % nig) % gsz); u.pn = (wgid % nig) / gsz; return true;
    }
    __device__ __forceinline__ void a_ready(const Unit&) const {}
    __device__ __forceinline__ void done(const Unit&) const {}
};
__device__ __forceinline__ unsigned cvt_pk_bf16(float lo, float hi) { unsigned r; asm volatile("v_cvt_pk_bf16_f32 %0, %1, %2" : "=v"(r) : "v"(lo), "v"(hi)); return r; }
template <class Epi, class Sched, bool ALIGN_EPI = false, bool SP2 = false>
__device__ __forceinline__ void gemm_phase(PG8_LAS unsigned char* lds, const Gemm g, const Sched& S, const Epi& E) {
    const int tid = threadIdx.x, wid = __builtin_amdgcn_readfirstlane(tid >> 6), lane = tid & 63, wr = wid >> 2, wc = wid & 3, fr = lane & 15, fq = lane >> 4;
    const int K = g.K, nt = K / BK;
    unsigned voffA[2], voffB[2];
#pragma unroll
    for (int i = 0; i < 2; ++i) { int R, C; stage_rc(tid * 16 + i * 8192, R, C); const int Rb = Epi::PERM ? ((R & ~31) + perm32(R & 31)) : R;
        voffA[i] = (unsigned)(R * K + C) * 2u; voffB[i] = (unsigned)(Rb * K + C) * 2u; }
    const size_t kstep = (size_t)(BK * 2);
    const size_t hstep = (size_t)HALF * K * 2;
    const size_t tstep = 2 * hstep;
    const unsigned ldsw = (unsigned)wid * 1024u;
    const int aoff = lds_byte(wr * 64 + fr, fq * 8), boff = lds_byte(wc * 32 + fr, fq * 8);
#define PG8_SA(b, h) (((b) * 2 + (h)) * HTB)
#define PG8_SB(b, h) ((4 + (b) * 2 + (h)) * HTB)
#define PG8_STAGE(bufoff, gbase, voff) do { _Pragma("unroll") for (int _i = 0; _i < 2; ++_i) \
        __builtin_amdgcn_global_load_lds((const unsigned*)((const char*)(gbase) + (voff)[_i]), (PG8_LAS unsigned*)(lds + (bufoff) + ldsw + _i * 8192), 16, 0, 0); } while (0)
#define PG8_LDA(dst, b, h) do { _Pragma("unroll") for (int m = 0; m < 4; ++m) _Pragma("unroll") for (int k = 0; k < 2; ++k) dst[m][k] = *(const PG8_LAS bf16x8*)(lds + PG8_SA(b, h) + aoff + m * 2048 + k * 1024); } while (0)
#define PG8_LDB(dst, b, h) do { _Pragma("unroll") for (int n = 0; n < 2; ++n) _Pragma("unroll") for (int k = 0; k < 2; ++k) dst[n][k] = *(const PG8_LAS bf16x8*)(lds + PG8_SB(b, h) + boff + n * 2048 + k * 1024); } while (0)
#define PG8_MMA(ai, bj, At, Bt) do { __builtin_amdgcn_s_setprio(1); _Pragma("unroll") for (int m = 0; m < 4; ++m) _Pragma("unroll") for (int n = 0; n < 2; ++n) _Pragma("unroll") for (int k = 0; k < 2; ++k) \
        acc[ai][bj][m][n] = __builtin_amdgcn_mfma_f32_16x16x32_bf16(Bt[n][k], At[m][k], acc[ai][bj][m][n], 0, 0, 0); __builtin_amdgcn_s_setprio(0); } while (0)
#define PG8_WAIT_V(n) asm volatile("s_waitcnt vmcnt(" #n ")" ::: "memory")
#define PG8_WAIT_L(n) asm volatile("s_waitcnt lgkmcnt(" #n ")" ::: "memory")
#define PG8_BAR __builtin_amdgcn_s_barrier()
#define PG8_SCHED __builtin_amdgcn_sched_barrier(0)
    Unit cur, nxt; int ui = 0;
    if (!S.next(0, cur)) return;
    f32x4 acc[2][2][4][2];
#pragma unroll
    for (int a = 0; a < 2; ++a)
#pragma unroll
        for (int b = 0; b < 2; ++b)
#pragma unroll
            for (int m = 0; m < 4; ++m)
#pragma unroll
                for (int n = 0; n < 2; ++n) acc[a][b][m][n] = (f32x4){0.f, 0.f, 0.f, 0.f};
    bf16x8 At[4][2], B0[2][2], B1[2][2];
    const char* cA = (const char*)g.A + (size_t)cur.pm * tstep; const char* cB = (const char*)g.Bt + (size_t)cur.pn * tstep;
    S.a_ready(cur);
    if constexpr (SP2) {
        PG8_STAGE(PG8_SB(0, 0), cB, voffB); PG8_STAGE(PG8_SB(0, 1), cB + hstep, voffB); PG8_STAGE(PG8_SA(0, 0), cA, voffA); PG8_STAGE(PG8_SA(0, 1), cA + hstep, voffA);
        if (wr == 1) PG8_BAR;
        PG8_WAIT_V(2); PG8_BAR;
        PG8_STAGE(PG8_SB(1, 0), cB + kstep, voffB); PG8_STAGE(PG8_SA(1, 0), cA + kstep, voffA); PG8_STAGE(PG8_SB(1, 1), cB + hstep + kstep, voffB);
        PG8_WAIT_V(6); PG8_BAR;
    } else {
        PG8_STAGE(PG8_SB(0, 0), cB, voffB); PG8_STAGE(PG8_SA(0, 0), cA, voffA); PG8_STAGE(PG8_SB(0, 1), cB + hstep, voffB); PG8_STAGE(PG8_SA(0, 1), cA + hstep, voffA);
        if (wr == 1) PG8_BAR;
        PG8_WAIT_V(4); PG8_BAR;
        PG8_STAGE(PG8_SB(1, 0), cB + kstep, voffB); PG8_STAGE(PG8_SA(1, 0), cA + kstep, voffA); PG8_STAGE(PG8_SB(1, 1), cB + hstep + kstep, voffB);
        PG8_WAIT_V(6); PG8_BAR;
    }
    for (;;) {
        const bool has_next = S.next(ui + 1, nxt);
        const char* nA = has_next ? (const char*)g.A + (size_t)nxt.pm * tstep : cA; const char* nB = has_next ? (const char*)g.Bt + (size_t)nxt.pn * tstep : cB;
        for (int t = 0; t < nt; t += 2) {
            const bool last = (t == nt - 2);
            const char* a1 = cA + (size_t)(t + 1) * kstep;
            const char* a2 = last ? nA : cA + (size_t)(t + 2) * kstep; const char* b2 = last ? nB : cB + (size_t)(t + 2) * kstep;
            const char* a3 = a2 + kstep; const char* b3 = b2 + kstep;
            if (last && has_next) S.a_ready(nxt);
            if constexpr (SP2) {
            PG8_LDB(B0, 0, 0); PG8_LDB(B1, 0, 1); PG8_SCHED; PG8_LDA(At, 0, 0); PG8_STAGE(PG8_SA(1, 1), a1 + hstep, voffA);
            PG8_WAIT_V(8); PG8_WAIT_L(0); PG8_BAR; PG8_MMA(0, 0, At, B0); PG8_MMA(0, 1, At, B1); PG8_BAR; PG8_SCHED;
            PG8_LDA(At, 0, 1); PG8_STAGE(PG8_SB(0, 0), b2, voffB); PG8_STAGE(PG8_SB(0, 1), b2 + hstep, voffB); PG8_STAGE(PG8_SA(0, 0), a2, voffA);
            PG8_WAIT_V(8); PG8_WAIT_L(0); PG8_BAR; PG8_MMA(1, 0, At, B0); PG8_MMA(1, 1, At, B1); PG8_BAR; PG8_SCHED;
            PG8_LDB(B0, 1, 0); PG8_LDB(B1, 1, 1); PG8_SCHED; PG8_LDA(At, 1, 0); PG8_STAGE(PG8_SA(0, 1), a2 + hstep, voffA);
            PG8_WAIT_V(8); PG8_WAIT_L(0); PG8_BAR; PG8_MMA(0, 0, At, B0); PG8_MMA(0, 1, At, B1); PG8_BAR; PG8_SCHED;
            PG8_LDA(At, 1, 1); PG8_STAGE(PG8_SB(1, 0), b3, voffB); PG8_STAGE(PG8_SB(1, 1), b3 + hstep, voffB); PG8_STAGE(PG8_SA(1, 0), a3, voffA);
            PG8_WAIT_V(8); PG8_WAIT_L(0); PG8_BAR; PG8_MMA(1, 0, At, B0); PG8_MMA(1, 1, At, B1); PG8_BAR; PG8_SCHED;
            } else {
            PG8_LDB(B0, 0, 0); PG8_SCHED; PG8_LDA(At, 0, 0); PG8_STAGE(PG8_SA(1, 1), a1 + hstep, voffA);
            PG8_WAIT_L(8); PG8_BAR; PG8_WAIT_L(0); PG8_MMA(0, 0, At, B0); PG8_BAR; PG8_SCHED;
            PG8_LDB(B1, 0, 1); PG8_STAGE(PG8_SB(0, 0), b2, voffB);
            PG8_BAR; PG8_WAIT_L(0); PG8_MMA(0, 1, At, B1); PG8_BAR;
            PG8_LDA(At, 0, 1); PG8_STAGE(PG8_SA(0, 0), a2, voffA);
            PG8_BAR; PG8_WAIT_L(0); PG8_MMA(1, 0, At, B0); PG8_BAR; PG8_SCHED;
            PG8_STAGE(PG8_SB(0, 1), b2 + hstep, voffB);
            PG8_WAIT_V(6); PG8_BAR; PG8_MMA(1, 1, At, B1); PG8_BAR;
            PG8_LDB(B0, 1, 0); PG8_SCHED; PG8_LDA(At, 1, 0); PG8_STAGE(PG8_SA(0, 1), a2 + hstep, voffA);
            PG8_WAIT_L(8); PG8_BAR; PG8_WAIT_L(0); PG8_MMA(0, 0, At, B0); PG8_BAR; PG8_SCHED;
            PG8_LDB(B1, 1, 1); PG8_STAGE(PG8_SB(1, 0), b3, voffB);
            PG8_BAR; PG8_WAIT_L(0); PG8_MMA(0, 1, At, B1); PG8_BAR;
            PG8_LDA(At, 1, 1); PG8_STAGE(PG8_SA(1, 0), a3, voffA);
            PG8_BAR; PG8_WAIT_L(0); PG8_MMA(1, 0, At, B0); PG8_BAR; PG8_SCHED;
            PG8_STAGE(PG8_SB(1, 1), b3 + hstep, voffB);
            PG8_WAIT_V(6); PG8_BAR; PG8_MMA(1, 1, At, B1); PG8_BAR;
            }
        }
        if constexpr (ALIGN_EPI) { if (wr == 0) PG8_BAR; }
        if constexpr (!Epi::AFTER_DRAIN) { E(acc, cur, wr, wc, fr, fq); S.done(cur); }
        if (!has_next) break;
#pragma unroll
        for (int a = 0; a < 2; ++a)
#pragma unroll
            for (int b = 0; b < 2; ++b)
#pragma unroll
                for (int m = 0; m < 4; ++m)
#pragma unroll
                    for (int n = 0; n < 2; ++n) acc[a][b][m][n] = (f32x4){0.f, 0.f, 0.f, 0.f};
        cur = nxt; cA = nA; cB = nB; ++ui;
        if constexpr (ALIGN_EPI) { if (wr == 1) PG8_BAR; }
    }
    PG8_WAIT_V(0);
    if constexpr (!ALIGN_EPI) { if (wr == 0) PG8_BAR; }
    PG8_BAR;
    if constexpr (Epi::AFTER_DRAIN) { E.fused(acc, cur, wr, wc, fr, fq, lds, wid, lane); S.done(cur); }
#undef PG8_SA
#undef PG8_SB
#undef PG8_STAGE
#undef PG8_LDA
#undef PG8_LDB
#undef PG8_MMA
#undef PG8_WAIT_V
#undef PG8_WAIT_L
#undef PG8_BAR
#undef PG8_SCHED
}
}

#define LAS __attribute__((address_space(3)))
typedef unsigned short bf16;
typedef unsigned char uchar;
typedef unsigned v4u __attribute__((ext_vector_type(4)));
typedef unsigned v2u __attribute__((ext_vector_type(2)));
typedef float f32x4 __attribute__((ext_vector_type(4)));
typedef short bf16x8 __attribute__((ext_vector_type(8)));
#define MFMA16(a, b, c) __builtin_amdgcn_mfma_f32_16x16x32_bf16((a), (b), (c), 0, 0, 0)

constexpr int T = 32768, DM = 1024, SEQ = 16384, NCHK = 256;
constexpr float EPS = 1e-6f;
constexpr size_t MiB = 1u << 20;
constexpr size_t WS_MOD = 0, WS_SS = 1 * MiB, WS_DEC = 3 * MiB, WS_SM = 6 * MiB, WS_HALO = 10 * MiB;
constexpr size_t WS_WIN = 20 * MiB, WS_WBG = 39 * MiB, WS_WBD = 41 * MiB, WS_WOUT = 43 * MiB, WS_W1 = 45 * MiB, WS_W2 = 53 * MiB;
constexpr size_t WS_WPK = 64 * MiB;
constexpr size_t WS_HB = 64 * MiB, WS_AQ = 128 * MiB, WS_AK = 160 * MiB, WS_AV = 192 * MiB, WS_DQ = 256 * MiB, WS_DK = 320 * MiB, WS_DV = 384 * MiB;
constexpr size_t WS_ATTD = 448 * MiB, WS_ATTA = 480 * MiB, WS_SSP = 496 * MiB, WS_END = 512 * MiB;
constexpr size_t WS_SGA = 128 * MiB, WS_SGD = 256 * MiB, WS_YA = 320 * MiB, WS_MG = 128 * MiB, WS_Z = 256 * MiB, WS_H2 = 64 * MiB, WS_A1 = 128 * MiB, WS_Y = 384 * MiB;
constexpr int WIN1_ROWS = 5376, WIN2_ROWS = 4096;
constexpr int LDS_BYTES = 147456;
constexpr int NPHASE = 14;

struct Params { const float* in[21]; float* out; uchar* ws; int lo, hi; };

__device__ __forceinline__ unsigned f2bf(float f) { unsigned u = __float_as_uint(f); return (u + 0x7fffu + ((u >> 16) & 1u)) >> 16; }
__device__ __forceinline__ unsigned pk2(float lo, float hi) { return f2bf(lo) | (f2bf(hi) << 16); }
__device__ __forceinline__ float bf2f(unsigned b) { return __uint_as_float(b << 16); }
__device__ __forceinline__ float bflo(unsigned w) { return __uint_as_float(w << 16); }
__device__ __forceinline__ float bfhi(unsigned w) { return __uint_as_float(w & 0xffff0000u); }
__device__ __forceinline__ bf16x8 pack8(f32x4 a, f32x4 b) { v4u p; p.x = pk2(a[0], a[1]); p.y = pk2(a[2], a[3]); p.z = pk2(b[0], b[1]); p.w = pk2(b[2], b[3]); return __builtin_bit_cast(bf16x8, p); }
__device__ __forceinline__ float wave_sum(float v) {
#pragma unroll
    for (int o = 1; o < 64; o <<= 1) v += __shfl_xor(v, o);
    return v;
}
__device__ __forceinline__ float sigmoidf_(float x) { return 1.0f / (1.0f + __expf(-x)); }
__device__ __forceinline__ float siluf_(float x) { return x / (1.0f + __expf(-x)); }
__device__ __forceinline__ float softplusf_(float x) { return fmaxf(x, 0.f) + log1pf(__expf(-fabsf(x))); }

__device__ __forceinline__ int win_dest_row(int j) {
    if (j < 2048) return j;
    if (j < 3072) return WIN1_ROWS + (j - 2048);
    if (j < 3088) return 5120 + (j - 3072);
    if (j < 6160) return 2048 + (j - 3088);
    if (j < 7184) return WIN1_ROWS + 1024 + (j - 6160);
    if (j < 7200) return 5136 + (j - 7184);
    return WIN1_ROWS + 2048 + (j - 7200);
}
template <bool REMAP>
__device__ __forceinline__ void tr_item(const float* W, int K, int N, bf16* WT, LAS float* scr, int item, int lane) {
    const int nblk = N / 32, kb = item / nblk, nb = item % nblk, k0 = 64 * kb, n0 = 32 * nb;
#pragma unroll 8
    for (int i = 0; i < 32; ++i) { const int kk = 2 * i + (lane >> 5); scr[kk * 33 + (lane & 31)] = W[(size_t)(k0 + kk) * N + n0 + (lane & 31)]; }
    asm volatile("s_waitcnt lgkmcnt(0)" ::: "memory");
    const int c = lane & 7;
#pragma unroll
    for (int j = 0; j < 4; ++j) { const int n = (lane >> 3) + 8 * j; const LAS float* s = scr + (8 * c) * 33 + n;
        v4u o; o.x = pk2(s[0 * 33], s[1 * 33]); o.y = pk2(s[2 * 33], s[3 * 33]); o.z = pk2(s[4 * 33], s[5 * 33]); o.w = pk2(s[6 * 33], s[7 * 33]);
        const int dr = REMAP ? win_dest_row(n0 + n) : (n0 + n);
        *(v4u*)(WT + (size_t)dr * K + k0 + 8 * c) = o; }
    asm volatile("s_waitcnt lgkmcnt(0)" ::: "memory");
}
__device__ __forceinline__ void phase0(const Params& P, LAS uchar* lds) {
    const int tid = threadIdx.x, lane = tid & 63, wave = tid >> 6;
    const int gw = blockIdx.x * 8 + wave, NGW = gridDim.x * 8;
    LAS float* scr = (LAS float*)(lds + wave * 16384);
    uchar* ws = P.ws;
    constexpr int I_IN = 16 * 289, I_SQ = 16 * 32, I_1 = 16 * 128, I_2 = 64 * 32;
    constexpr int NITEMS = I_IN + 3 * I_SQ + I_1 + I_2;
    for (int it = gw; it < NITEMS; it += NGW) {
        int r = it;
        if (r < I_IN) { tr_item<true>(P.in[8], 1024, 9248, (bf16*)(ws + WS_WIN), scr, r, lane); continue; } r -= I_IN;
        if (r < I_SQ) { tr_item<false>(P.in[16], 1024, 1024, (bf16*)(ws + WS_WBG), scr, r, lane); continue; } r -= I_SQ;
        if (r < I_SQ) { tr_item<false>(P.in[17], 1024, 1024, (bf16*)(ws + WS_WBD), scr, r, lane); continue; } r -= I_SQ;
        if (r < I_SQ) { tr_item<false>(P.in[18], 1024, 1024, (bf16*)(ws + WS_WOUT), scr, r, lane); continue; } r -= I_SQ;
        if (r < I_1) { tr_item<false>(P.in[19], 1024, 4096, (bf16*)(ws + WS_W1), scr, r, lane); continue; } r -= I_1;
        tr_item<false>(P.in[20], 4096, 1024, (bf16*)(ws + WS_W2), scr, r, lane);
    }
    { v4u* z = (v4u*)(ws + WS_WIN + (size_t)5152 * 2048); const int n16 = 224 * 128; const v4u zz = {0u, 0u, 0u, 0u};
      for (int i = blockIdx.x * 512 + tid; i < n16; i += gridDim.x * 512) z[i] = zz; }
    float* mod = (float*)(ws + WS_MOD);
    const float* cvec = P.in[1]; const float* aw = P.in[2]; const float* ab = P.in[3];
    for (int task = gw; task < 384; task += NGW) {
        const int cq = lane & 3, rg = lane >> 2, col = task * 16 + cq * 4;
        f32x4 a0 = {0.f, 0.f, 0.f, 0.f}, a1 = {0.f, 0.f, 0.f, 0.f};
#pragma unroll 8
        for (int i = 0; i < 64; ++i) { const int k = rg + 16 * i;
            const float s0 = siluf_(cvec[k]), s1 = siluf_(cvec[1024 + k]);
            const f32x4 w = *(const f32x4*)(aw + (size_t)k * 6144 + col);
            a0 += w * s0; a1 += w * s1; }
#pragma unroll
        for (int e = 0; e < 4; ++e) {
#pragma unroll
            for (int o = 4; o < 64; o <<= 1) { a0[e] += __shfl_xor(a0[e], o); a1[e] += __shfl_xor(a1[e], o); } }
        if (rg == 0) { const f32x4 bb = *(const f32x4*)(ab + col); *(f32x4*)(mod + col) = a0 + bb; *(f32x4*)(mod + 6144 + col) = a1 + bb; }
    }
}

__device__ __forceinline__ void phase_norm1(const Params& P) {
    const int tid = threadIdx.x, lane = tid & 63, wave = tid >> 6;
    const int gw = blockIdx.x * 8 + wave, NGW = gridDim.x * 8;
    const float* x = P.in[0]; const float* w = P.in[4]; const float* mod = (const float*)(P.ws + WS_MOD);
    bf16* hb = (bf16*)(P.ws + WS_HB);
    for (int m = gw; m < T; m += NGW) {
        const int b = m / SEQ; const float* mb = mod + b * 6144;
        const f32x4* xr = (const f32x4*)(x + (size_t)m * DM) + lane;
        f32x4 v[4]; float s = 0.f;
#pragma unroll
        for (int j = 0; j < 4; ++j) { v[j] = xr[64 * j]; s += (v[j][0] * v[j][0] + v[j][1] * v[j][1]) + (v[j][2] * v[j][2] + v[j][3] * v[j][3]); }
        const float r = rsqrtf(wave_sum(s) * (1.f / DM) + EPS);
        v2u* o = (v2u*)(hb + (size_t)m * DM) + lane;
#pragma unroll
        for (int j = 0; j < 4; ++j) { const int col = 4 * (lane + 64 * j);
            const f32x4 ww = *(const f32x4*)(w + col), sc = *(const f32x4*)(mb + 1024 + col), sh = *(const f32x4*)(mb + col);
            const f32x4 y = v[j] * r * ww * (sc + 1.0f) + sh;
            v2u q; q.x = pk2(y[0], y[1]); q.y = pk2(y[2], y[3]); o[64 * j] = q; }
    }
}
__device__ __forceinline__ void phase_row1(const Params& P) {
    const int tid = threadIdx.x, lane = tid & 63, wave = tid >> 6;
    const int gw = blockIdx.x * 8 + wave, NGW = gridDim.x * 8;
    const float* x = P.in[0]; const float* wpost = P.in[5]; const float* wpre = P.in[6]; const float* mod = (const float*)(P.ws + WS_MOD);
    const bf16* zb = (const bf16*)(P.ws + WS_Z); bf16* h2 = (bf16*)(P.ws + WS_H2);
    for (int m = gw; m < T; m += NGW) {
        const int b = m / SEQ; const float* mb = mod + b * 6144;
        const f32x4* xr = (const f32x4*)(x + (size_t)m * DM) + lane; const v2u* zr = (const v2u*)(zb + (size_t)m * DM) + lane;
        f32x4 v[4], z[4]; float s = 0.f;
#pragma unroll
        for (int j = 0; j < 4; ++j) { v[j] = xr[64 * j]; const v2u q = zr[64 * j]; z[j] = (f32x4){bflo(q.x), bfhi(q.x), bflo(q.y), bfhi(q.y)};
            s += (z[j][0] * z[j][0] + z[j][1] * z[j][1]) + (z[j][2] * z[j][2] + z[j][3] * z[j][3]); }
        const float r1 = rsqrtf(wave_sum(s) * (1.f / DM) + EPS); float s2 = 0.f;
        f32x4* orow = (f32x4*)(P.out + (size_t)m * DM) + lane;
#pragma unroll
        for (int j = 0; j < 4; ++j) { const int col = 4 * (lane + 64 * j);
            const f32x4 ww = *(const f32x4*)(wpost + col), g1 = *(const f32x4*)(mb + 2048 + col);
            v[j] = v[j] + g1 * (z[j] * r1 * ww); orow[64 * j] = v[j];
            s2 += (v[j][0] * v[j][0] + v[j][1] * v[j][1]) + (v[j][2] * v[j][2] + v[j][3] * v[j][3]); }
        const float r2 = rsqrtf(wave_sum(s2) * (1.f / DM) + EPS);
        v2u* o = (v2u*)(h2 + (size_t)m * DM) + lane;
#pragma unroll
        for (int j = 0; j < 4; ++j) { const int col = 4 * (lane + 64 * j);
            const f32x4 ww = *(const f32x4*)(wpre + col), sc = *(const f32x4*)(mb + 4096 + col), sh = *(const f32x4*)(mb + 3072 + col);
            const f32x4 y = v[j] * r2 * ww * (sc + 1.0f) + sh;
            v2u q; q.x = pk2(y[0], y[1]); q.y = pk2(y[2], y[3]); o[64 * j] = q; }
    }
}
__device__ __forceinline__ void phase_row2(const Params& P) {
    const int tid = threadIdx.x, lane = tid & 63, wave = tid >> 6;
    const int gw = blockIdx.x * 8 + wave, NGW = gridDim.x * 8;
    const float* wpost = P.in[7]; const float* mod = (const float*)(P.ws + WS_MOD);
    const bf16* yb = (const bf16*)(P.ws + WS_Y);
    for (int m = gw; m < T; m += NGW) {
        const int b = m / SEQ; const float* mb = mod + b * 6144;
        f32x4* orow = (f32x4*)(P.out + (size_t)m * DM) + lane; const v2u* yr = (const v2u*)(yb + (size_t)m * DM) + lane;
        f32x4 v[4], z[4]; float s = 0.f;
#pragma unroll
        for (int j = 0; j < 4; ++j) { v[j] = orow[64 * j]; const v2u q = yr[64 * j]; z[j] = (f32x4){bflo(q.x), bfhi(q.x), bflo(q.y), bfhi(q.y)};
            s += (z[j][0] * z[j][0] + z[j][1] * z[j][1]) + (z[j][2] * z[j][2] + z[j][3] * z[j][3]); }
        const float r1 = rsqrtf(wave_sum(s) * (1.f / DM) + EPS);
#pragma unroll
        for (int j = 0; j < 4; ++j) { const int col = 4 * (lane + 64 * j);
            const f32x4 ww = *(const f32x4*)(wpost + col), g2 = *(const f32x4*)(mb + 5120 + col);
            orow[64 * j] = v[j] + g2 * (z[j] * r1 * ww); }
    }
}

__device__ __forceinline__ v4u pack8f(const float (&v)[8]) { v4u w; w.x = pg8::cvt_pk_bf16(v[0], v[1]); w.y = pg8::cvt_pk_bf16(v[2], v[3]); w.z = pg8::cvt_pk_bf16(v[4], v[5]); w.w = pg8::cvt_pk_bf16(v[6], v[7]); return w; }
__device__ __forceinline__ void unpack8(const v4u q, float (&o)[8]) { o[0] = bflo(q.x); o[1] = bfhi(q.x); o[2] = bflo(q.y); o[3] = bfhi(q.y); o[4] = bflo(q.z); o[5] = bfhi(q.z); o[6] = bflo(q.w); o[7] = bfhi(q.w); }
#ifndef DBG_BRD_EXPR
#define DBG_BRD_EXPR (mg[e] + g[e] * v[e])
#endif
#ifndef PG8_ALIGN
#define PG8_ALIGN true
#endif
#ifndef PG8_SP2
#define PG8_SP2 true
#endif
enum { M_INPROJ = 0, M_GATES = 1, M_BRA = 2, M_BRD = 3, M_OUT = 4, M_MLP1 = 5, M_MLP2 = 6 };
template <int MODE> struct Epi {
    static constexpr bool PERM = true, AFTER_DRAIN = false;
    uchar* ws; const float* p0; const float* p1;
    __device__ __forceinline__ void operator()(const pg8::f32x4 (&acc)[2][2][4][2], const pg8::Unit& u, int wr, int wc, int fr, int fq) const {
        const int pn = u.pn;
#pragma unroll
        for (int ai = 0; ai < 2; ++ai)
#pragma unroll
            for (int m = 0; m < 4; ++m) {
                const int row = u.pm * 256 + ai * 128 + wr * 64 + m * 16 + fr;
#pragma unroll
                for (int bj = 0; bj < 2; ++bj) {
                    const int cu = bj * 128 + wc * 32 + 8 * fq;
                    const pg8::f32x4 v0 = acc[ai][bj][m][0], v1 = acc[ai][bj][m][1];
                    float v[8] = {v0[0], v0[1], v0[2], v0[3], v1[0], v1[1], v1[2], v1[3]};
                    if constexpr (MODE == M_INPROJ) {
                        if (pn < 20) {
                            bf16* base; int ld, col;
                            if (pn < 2) { base = (bf16*)(ws + WS_AQ); ld = 512; col = pn * 256 + cu; }
                            else if (pn < 4) { base = (bf16*)(ws + WS_AK); ld = 512; col = (pn - 2) * 256 + cu; }
                            else { base = (bf16*)(ws + WS_AV + (size_t)((pn - 4) >> 2) * (64 * MiB)); ld = 1024; col = ((pn - 4) & 3) * 256 + cu; }
                            const v4u w = pack8f(v);
                            *(v4u*)(base + (size_t)row * ld + col) = w;
                            if (m == 3) { if (pn >= 8 && fr >= 13) { const int chunk = row >> 6, hr = (row & 63) - 61;
                                *(v4u*)((bf16*)(ws + WS_HALO) + ((size_t)chunk * 3 + hr) * 3072 + (pn - 8) * 256 + cu) = w; } }
                        } else if (bj == 0) { if (wc == 0) { float* sm = (float*)(ws + WS_SM) + (size_t)row * 32 + 8 * fq;
                            *(pg8::f32x4*)sm = v0; *(pg8::f32x4*)(sm + 4) = v1; } }
                    } else if constexpr (MODE == M_GATES) {
                        if (pn < 8) {
                            bf16* O; int col, slot; float invd; const float* ow;
                            if (pn < 4) { O = (bf16*)(ws + WS_AV); col = pn * 256 + cu; slot = 8 + pn; invd = 1.f / 256.f; ow = p0 + cu; }
                            else { O = (bf16*)(ws + WS_DV); col = (pn - 4) * 256 + cu; slot = col >> 7; invd = 1.f / 128.f; ow = p1 + (col & 127); }
                            const float* sp = (const float*)(ws + WS_SSP) + (size_t)row * 128 + (pn < 4 ? 64 + pn * 16 : slot * 8);
                            float ssv;
                            { const pg8::f32x4 q0 = *(const pg8::f32x4*)sp, q1 = *(const pg8::f32x4*)(sp + 4);
                              ssv = ((q0[0] + q0[1]) + (q0[2] + q0[3])) + ((q1[0] + q1[1]) + (q1[2] + q1[3]));
                              if (pn < 4) { const pg8::f32x4 q2 = *(const pg8::f32x4*)(sp + 8), q3 = *(const pg8::f32x4*)(sp + 12);
                                  ssv += ((q2[0] + q2[1]) + (q2[2] + q2[3])) + ((q3[0] + q3[1]) + (q3[2] + q3[3])); } }
                            const float r = rsqrtf(ssv * invd + EPS);
                            bf16* op = O + (size_t)row * 1024 + col;
                            float o[8]; unpack8(*(const v4u*)op, o);
                            const pg8::f32x4 w0 = *(const pg8::f32x4*)ow, w1 = *(const pg8::f32x4*)(ow + 4);
                            const float wv[8] = {w0[0], w0[1], w0[2], w0[3], w1[0], w1[1], w1[2], w1[3]};
#pragma unroll
                            for (int e = 0; e < 8; ++e) v[e] = o[e] * r * wv[e] * siluf_(v[e]);
                            *(v4u*)op = pack8f(v);
                        } else {
                            bf16* G = (bf16*)(ws + (pn < 12 ? WS_SGA : WS_SGD)); const int col = ((pn - 8) & 3) * 256 + cu;
#pragma unroll
                            for (int e = 0; e < 8; ++e) v[e] = sigmoidf_(v[e]);
                            *(v4u*)(G + (size_t)row * 1024 + col) = pack8f(v);
                        }
                    } else if constexpr (MODE == M_BRA) {
                        const size_t off = (size_t)row * 1024 + pn * 256 + cu;
                        float g[8]; unpack8(*(const v4u*)((const bf16*)(ws + WS_SGA) + off), g);
#pragma unroll
                        for (int e = 0; e < 8; ++e) v[e] = g[e] * v[e];
                        *(v4u*)((bf16*)(ws + WS_YA) + off) = pack8f(v);
                    } else if constexpr (MODE == M_BRD) {
                        const size_t off = (size_t)row * 1024 + pn * 256 + cu;
                        float g[8], mg[8]; unpack8(*(const v4u*)((const bf16*)(ws + WS_SGD) + off), g); unpack8(*(const v4u*)((const bf16*)(ws + WS_YA) + off), mg);
#pragma unroll
                        for (int e = 0; e < 8; ++e) v[e] = DBG_BRD_EXPR;
                        *(v4u*)((bf16*)(ws + WS_MG) + off) = pack8f(v);
                    } else if constexpr (MODE == M_OUT) {
                        *(v4u*)((bf16*)(ws + WS_Z) + (size_t)row * 1024 + pn * 256 + cu) = pack8f(v);
                    } else if constexpr (MODE == M_MLP1) {
#pragma unroll
                        for (int e = 0; e < 8; ++e) { const float t = fmaxf(v[e], 0.f); v[e] = t * t; }
                        *(v4u*)((bf16*)(ws + WS_A1) + (size_t)row * 4096 + pn * 256 + cu) = pack8f(v);
                    } else {
                        *(v4u*)((bf16*)(ws + WS_Y) + (size_t)row * 1024 + pn * 256 + cu) = pack8f(v);
                    }
                }
            }
    }
};
template <int MODE>
__device__ __forceinline__ void run_gemm(LAS uchar* lds, const bf16* A, const bf16* Bt, int N, int K, uchar* ws, const float* p0, const float* p1) {
    pg8::Gemm g{A, Bt, T, N, K}; pg8::StaticOrder S; S.init(T, N, (int)gridDim.x, (int)blockIdx.x);
    Epi<MODE> E{ws, p0, p1};
    pg8::gemm_phase<Epi<MODE>, pg8::StaticOrder, PG8_ALIGN, PG8_SP2>((PG8_LAS unsigned char*)lds, g, S, E);
}

constexpr int LP = 136;
constexpr int PL_Q = 0, PL_K = 17408, PL_V = 34816, PL_W = 52224, PL_AM = 69632, PL_SM = 86016;
constexpr float QSCALE = 0.08838834764831845f;

__device__ __forceinline__ uchar* reg_addr(uchar* base, int pitch, int q) { return base + (size_t)(q >> 8) * pitch + (q & 255); }

template <bool GDN>
__device__ __forceinline__ void att_frag(LAS uchar* lds, int wave, int lane, const LAS float* gc, bf16* attdst) {
    const int ntq = wave >> 1, kt2 = wave & 1, c = lane & 15, rq = lane >> 4;
    f32x4 d[2];
#pragma unroll
    for (int hh = 0; hh < 2; ++hh) {
        const int mtk = 2 * kt2 + hh; f32x4 acc = {0.f, 0.f, 0.f, 0.f};
#pragma unroll
        for (int kt = 0; kt < 4; ++kt) {
            const bf16x8 a = *(const LAS bf16x8*)(lds + PL_K + ((16 * mtk + c) * LP + 32 * kt + 8 * rq) * 2);
            const bf16x8 b = *(const LAS bf16x8*)(lds + PL_Q + ((16 * ntq + c) * LP + 32 * kt + 8 * rq) * 2);
            acc = MFMA16(a, b, acc);
        }
        const int i = 16 * ntq + c;
#pragma unroll
        for (int jj = 0; jj < 4; ++jj) { const int jp = 16 * mtk + 4 * rq + jj;
            float val = acc[jj];
            if (GDN) val *= QSCALE * __expf(gc[i] - gc[jp]);
            acc[jj] = (jp <= i) ? val : 0.f; }
        d[hh] = acc;
    }
    *(bf16x8*)(attdst + ((ntq * 2 + kt2) * 64 + lane) * 8) = pack8(d[0], d[1]);
}

__device__ __forceinline__ void prep_gdn(const Params& P, LAS uchar* lds, int item) {
    const int tid = threadIdx.x, lane = tid & 63, wave = tid >> 6;
    const int b = item >> 11, n = (item >> 3) & 255, h = item & 7;
    const int t0 = b * SEQ + n * 64;
    uchar* ws = P.ws;
    LAS float* beta = (LAS float*)(lds + PL_SM); LAS float* gc = beta + 64; LAS float* eg = beta + 128;
    {
        const float* cw = P.in[12];
        const bf16* halo = (const bf16*)(ws + WS_HALO);
#pragma unroll 1
        for (int e = 0; e < 6; ++e) {
            const int z = e >> 1, i = (tid >> 4) + 32 * (e & 1), gq = tid & 15;
            const bf16* src = (const bf16*)(ws + WS_DQ + (size_t)z * (64 * MiB));
            const int ccol = z * 1024 + h * 128 + gq * 8;
            float y[8] = {0.f, 0.f, 0.f, 0.f, 0.f, 0.f, 0.f, 0.f};
#pragma unroll
            for (int jr = 0; jr < 4; ++jr) {
                const int ri = i - 3 + jr;
                v4u xv = {0u, 0u, 0u, 0u};
                if (ri >= 0) xv = *(const v4u*)(src + (size_t)(t0 + ri) * 1024 + h * 128 + gq * 8);
                else if (n > 0) xv = *(const v4u*)(halo + ((size_t)(b * NCHK + n - 1) * 3 + (ri + 3)) * 3072 + ccol);
                float xf[8]; unpack8(xv, xf);
                const f32x4 w0 = *(const f32x4*)(cw + jr * 3072 + ccol), w1 = *(const f32x4*)(cw + jr * 3072 + ccol + 4);
                y[0] += w0[0] * xf[0]; y[1] += w0[1] * xf[1]; y[2] += w0[2] * xf[2]; y[3] += w0[3] * xf[3];
                y[4] += w1[0] * xf[4]; y[5] += w1[1] * xf[5]; y[6] += w1[2] * xf[6]; y[7] += w1[3] * xf[7];
            }
            float ssq = 0.f;
#pragma unroll
            for (int k = 0; k < 8; ++k) { y[k] = siluf_(y[k]); ssq += y[k] * y[k]; }
            if (z < 2) {
                ssq += __shfl_xor(ssq, 1); ssq += __shfl_xor(ssq, 2); ssq += __shfl_xor(ssq, 4); ssq += __shfl_xor(ssq, 8);
                const float r = rsqrtf(ssq + EPS);
#pragma unroll
                for (int k = 0; k < 8; ++k) y[k] *= r;
            }
            v4u o; o.x = pk2(y[0], y[1]); o.y = pk2(y[2], y[3]); o.z = pk2(y[4], y[5]); o.w = pk2(y[6], y[7]);
            *(LAS v4u*)(lds + z * 17408 + (i * LP + gq * 8) * 2) = o;
        }
    }
    if (wave == 0) {
        const float* sm = (const float*)(ws + WS_SM) + (size_t)(t0 + lane) * 32;
        const float bt = sigmoidf_(sm[16 + h]);
        float g = -__expf(P.in[13][h]) * softplusf_(sm[24 + h] + P.in[14][h]);
#pragma unroll
        for (int o = 1; o < 64; o <<= 1) { const float t = __shfl_up(g, o); if (lane >= o) g += t; }
        beta[lane] = bt; gc[lane] = g; eg[lane] = __expf(g);
    }
    __syncthreads();
    const float glast = gc[63];
    {
        const int c = lane & 15, rq = lane >> 4, mt = wave >> 1;
        LAS float* am = (LAS float*)(lds + PL_AM);
#pragma unroll
        for (int hh = 0; hh < 2; ++hh) {
            const int nt = 2 * (wave & 1) + hh; f32x4 acc = {0.f, 0.f, 0.f, 0.f};
#pragma unroll
            for (int kt = 0; kt < 4; ++kt) {
                const bf16x8 a = *(const LAS bf16x8*)(lds + PL_K + ((16 * mt + c) * LP + 32 * kt + 8 * rq) * 2);
                const bf16x8 bb = *(const LAS bf16x8*)(lds + PL_K + ((16 * nt + c) * LP + 32 * kt + 8 * rq) * 2);
                acc = MFMA16(a, bb, acc);
            }
            const int j = 16 * nt + c;
#pragma unroll
            for (int jj = 0; jj < 4; ++jj) { const int i = 16 * mt + 4 * rq + jj;
                am[i * 64 + j] = (j < i) ? beta[i] * acc[jj] * __expf(gc[i] - gc[j]) : 0.f; }
        }
        att_frag<true>(lds, wave, lane, gc, (bf16*)(ws + WS_ATTD) + ((size_t)(b * NCHK + n) * 8 + h) * 4096);
    }
    __syncthreads();
    uchar* rQ = ws + WS_DQ + ((size_t)t0 * 1024 + h * 128) * 2;
    uchar* rK = ws + WS_DK + ((size_t)t0 * 1024 + h * 128) * 2;
    uchar* rU = ws + WS_DV + ((size_t)t0 * 1024 + h * 128) * 2;
    if (tid < 256) {
        const int cc = tid; float x[64];
        const LAS bf16* colp = (const LAS bf16*)(lds + (cc < 128 ? PL_V : PL_K)) + (cc & 127);
        int vzero; asm volatile("v_mov_b32 %0, 0" : "=v"(vzero));
        const LAS float* betav = beta + vzero; const LAS float* egv = eg + vzero;
#pragma unroll
        for (int j = 0; j < 64; ++j) { float r = betav[j] * bf2f(colp[j * LP]); if (cc >= 128) r *= egv[j]; x[j] = r; }
        const LAS float* am = (const LAS float*)(lds + PL_AM) + vzero;
#pragma unroll
        for (int i = 1; i < 64; ++i) {
            float acc = x[i];
#pragma unroll
            for (int j4 = 0; j4 < (i + 3) / 4; ++j4) {
                const f32x4 a = *(const LAS f32x4*)(am + i * 64 + 4 * j4);
#pragma unroll
                for (int e = 0; e < 4; ++e) if (4 * j4 + e < i) acc -= a[e] * x[4 * j4 + e];
            }
            x[i] = acc;
            asm volatile("" ::: "memory");
        }
        if (cc < 128) {
            const int sl = cc >> 4, c = cc & 15;
#pragma unroll
            for (int mt = 0; mt < 4; ++mt)
#pragma unroll
                for (int rq = 0; rq < 4; ++rq) { const int r0 = 16 * mt + 4 * rq;
                    v2u o; o.x = pk2(x[r0], x[r0 + 1]); o.y = pk2(x[r0 + 2], x[r0 + 3]);
                    *(v2u*)reg_addr(rU, 2048, ((sl * 4 + mt) * 64 + rq * 16 + c) * 8) = o; }
        } else {
            LAS bf16* wl = (LAS bf16*)(lds + PL_W) + (cc - 128);
#pragma unroll
            for (int i = 0; i < 64; ++i) wl[i * LP] = (bf16)f2bf(-x[i]);
        }
    } else {
        const int t2 = tid - 256;
#pragma unroll
        for (int e = 0; e < 4; ++e) {
            const int fl = t2 + 256 * e, mt = fl >> 8, kt = (fl >> 6) & 3, r = fl & 15, kq = (fl >> 4) & 3, i = 16 * mt + r;
            const v2u a = *(const LAS v2u*)(lds + PL_Q + (i * LP + 32 * kt + 4 * kq) * 2), bq = *(const LAS v2u*)(lds + PL_Q + (i * LP + 32 * kt + 16 + 4 * kq) * 2);
            const float f = QSCALE * eg[i];
            v4u o; o.x = pk2(bflo(a.x) * f, bfhi(a.x) * f); o.y = pk2(bflo(a.y) * f, bfhi(a.y) * f); o.z = pk2(bflo(bq.x) * f, bfhi(bq.x) * f); o.w = pk2(bflo(bq.y) * f, bfhi(bq.y) * f);
            *(v4u*)reg_addr(rQ, 2048, fl * 16) = o;
        }
#pragma unroll
        for (int e = 0; e < 4; ++e) {
            const int fl = t2 + 256 * e, mt8 = fl >> 7, kt2 = (fl >> 6) & 1, r = fl & 15, kq = (fl >> 4) & 3, d = 16 * mt8 + r;
            float vv[8];
#pragma unroll
            for (int s = 0; s < 8; ++s) { const int j = 32 * kt2 + (s < 4 ? 4 * kq + s : 16 + 4 * kq + s - 4);
                vv[s] = bf2f(((const LAS bf16*)(lds + PL_K))[j * LP + d]) * __expf(glast - gc[j]); }
            v4u o; o.x = pk2(vv[0], vv[1]); o.y = pk2(vv[2], vv[3]); o.z = pk2(vv[4], vv[5]); o.w = pk2(vv[6], vv[7]);
            *(v4u*)reg_addr(rK, 2048, fl * 16) = o;
        }
        if (t2 < 128) ((float*)(ws + WS_DEC))[((size_t)(b * NCHK + n) * 12 + h) * 128 + t2] = __expf(glast);
    }
    __syncthreads();
    {
        bf16* wdst = (bf16*)(ws + WS_WPK) + ((size_t)(b * NCHK + n) * 8 + h) * 8192;
#pragma unroll
        for (int e = 0; e < 2; ++e) {
            const int fl = tid + 512 * e, mt = fl >> 8, kt = (fl >> 6) & 3, r = fl & 15, kq = (fl >> 4) & 3, i = 16 * mt + r;
            const v2u a = *(const LAS v2u*)(lds + PL_W + (i * LP + 32 * kt + 4 * kq) * 2), bq = *(const LAS v2u*)(lds + PL_W + (i * LP + 32 * kt + 16 + 4 * kq) * 2);
            v4u o; o.x = a.x; o.y = a.y; o.z = bq.x; o.w = bq.y;
            *(v4u*)(wdst + fl * 8) = o;
        }
    }
    __syncthreads();
}

constexpr int GL_V = 34816, GL_ALR = 68608, GL_BQ = 72704, GL_BL = 74752, VP = 264;
__device__ __forceinline__ void prep_gla(const Params& P, LAS uchar* lds, int item) {
    const int tid = threadIdx.x, lane = tid & 63, wave = tid >> 6;
    const int b = item >> 10, n = (item >> 2) & 255, h = item & 3;
    const int t0 = b * SEQ + n * 64;
    uchar* ws = P.ws;
    LAS float* alr = (LAS float*)(lds + GL_ALR); LAS float* bqs = (LAS float*)(lds + GL_BQ); LAS float* bl = (LAS float*)(lds + GL_BL);
    if (tid < 256) { const int i = tid >> 2, r4 = (tid & 3) * 4;
        *(LAS f32x4*)(alr + i * 16 + r4) = *(const f32x4*)((const float*)(ws + WS_SM) + (size_t)(t0 + i) * 32 + r4); }
#pragma unroll
    for (int e = 0; e < 4; ++e) { const int p = tid + 512 * e, i = p >> 5, g8 = p & 31;
        *(LAS v4u*)(lds + GL_V + (i * VP + g8 * 8) * 2) = *(const v4u*)((const bf16*)(ws + WS_AV) + (size_t)(t0 + i) * 1024 + h * 256 + g8 * 8); }
    __syncthreads();
    const int d = tid & 127, qt = tid >> 7;
    float bloc[16];
    {
        const float* wlr = P.in[9] + h * 128 + d; float wl[16];
#pragma unroll
        for (int r = 0; r < 16; ++r) wl[r] = wlr[r * 512];
        const float bias = P.in[10][h * 128 + d]; float run = 0.f;
#pragma unroll
        for (int ii = 0; ii < 16; ++ii) { const int i = 16 * qt + ii; float z = bias;
#pragma unroll
            for (int r4 = 0; r4 < 4; ++r4) { const f32x4 a = *(const LAS f32x4*)(alr + i * 16 + 4 * r4);
                z += a[0] * wl[4 * r4] + a[1] * wl[4 * r4 + 1] + a[2] * wl[4 * r4 + 2] + a[3] * wl[4 * r4 + 3]; }
            run += -softplusf_(-z) * (1.f / 16.f); bloc[ii] = run; }
        bqs[qt * 128 + d] = run;
    }
    __syncthreads();
    {
        float off = 0.f, tot = 0.f;
#pragma unroll
        for (int q = 0; q < 4; ++q) { const float t = bqs[q * 128 + d]; if (q < qt) off += t; tot += t; }
        const bf16* aq = (const bf16*)(ws + WS_AQ) + (size_t)t0 * 512 + h * 128 + d;
        const bf16* ak = (const bf16*)(ws + WS_AK) + (size_t)t0 * 512 + h * 128 + d;
#pragma unroll
        for (int ii = 0; ii < 16; ++ii) { const int i = 16 * qt + ii; const float bi = off + bloc[ii];
            const float qv = bf2f(aq[(size_t)i * 512]) * QSCALE * __expf(bi), kv = bf2f(ak[(size_t)i * 512]) * __expf(-bi);
            ((LAS bf16*)(lds + PL_Q))[i * LP + d] = (bf16)f2bf(qv); ((LAS bf16*)(lds + PL_K))[i * LP + d] = (bf16)f2bf(kv); }
        if (qt == 0) { bl[d] = tot; ((float*)(ws + WS_DEC))[((size_t)(b * NCHK + n) * 12 + 8 + h) * 128 + d] = __expf(tot); }
    }
    __syncthreads();
    att_frag<false>(lds, wave, lane, nullptr, (bf16*)(ws + WS_ATTA) + ((size_t)(b * NCHK + n) * 4 + h) * 4096);
    uchar* rQ = ws + WS_AQ + ((size_t)t0 * 512 + h * 128) * 2;
    uchar* rK = ws + WS_AK + ((size_t)t0 * 512 + h * 128) * 2;
#pragma unroll
    for (int e = 0; e < 2; ++e) {
        const int fl = tid + 512 * e, mt = fl >> 8, kt = (fl >> 6) & 3, r = fl & 15, kq = (fl >> 4) & 3, i = 16 * mt + r;
        const v2u a = *(const LAS v2u*)(lds + PL_Q + (i * LP + 32 * kt + 4 * kq) * 2), bq = *(const LAS v2u*)(lds + PL_Q + (i * LP + 32 * kt + 16 + 4 * kq) * 2);
        v4u o; o.x = a.x; o.y = a.y; o.z = bq.x; o.w = bq.y;
        *(v4u*)reg_addr(rQ, 1024, fl * 16) = o;
    }
#pragma unroll
    for (int e = 0; e < 2; ++e) {
        const int fl = tid + 512 * e, mt8 = fl >> 7, kt2 = (fl >> 6) & 1, r = fl & 15, kq = (fl >> 4) & 3, dd = 16 * mt8 + r;
        const float f = __expf(bl[dd]); float vv[8];
#pragma unroll
        for (int s = 0; s < 8; ++s) { const int j = 32 * kt2 + (s < 4 ? 4 * kq + s : 16 + 4 * kq + s - 4);
            vv[s] = bf2f(((const LAS bf16*)(lds + PL_K))[j * LP + dd]) * f; }
        v4u o; o.x = pk2(vv[0], vv[1]); o.y = pk2(vv[2], vv[3]); o.z = pk2(vv[4], vv[5]); o.w = pk2(vv[6], vv[7]);
        *(v4u*)reg_addr(rK, 1024, fl * 16) = o;
    }
#pragma unroll
    for (int e = 0; e < 8; ++e) {
        const int it = tid + 512 * e, g = it >> 11, sl = (it >> 8) & 7, mt = (it >> 6) & 3, ln = it & 63, c = ln & 15, rq = ln >> 4;
        const LAS bf16* vp = (const LAS bf16*)(lds + GL_V) + (16 * mt + 4 * rq) * VP + g * 128 + sl * 16 + c;
        v2u o; o.x = (unsigned)vp[0] | ((unsigned)vp[VP] << 16); o.y = (unsigned)vp[2 * VP] | ((unsigned)vp[3 * VP] << 16);
        uchar* rU = ws + WS_AV + ((size_t)t0 * 1024 + h * 256 + g * 128) * 2;
        *(v2u*)reg_addr(rU, 2048, ((sl * 4 + mt) * 64 + ln) * 8) = o;
    }
    __syncthreads();
}

constexpr int SC_BUF = 57856;
__device__ __forceinline__ void phase_scan(const Params& P, LAS uchar* lds) {
    const int su = blockIdx.x; if (su >= 32) return;
    const int tid = threadIdx.x, lane = tid & 63, s = tid >> 6, c = lane & 15, rq = lane >> 4;
    const bool gdn = su < 16;
    int b, h, g = 0; if (gdn) { b = su >> 3; h = su & 7; } else { const int v = su - 16; b = v >> 3; h = (v & 7) >> 1; g = v & 1; }
    uchar* ws = P.ws;
    const uchar *pW, *pQ, *pK, *pA, *pD; uchar* pU; size_t sW, sQ, sA; int pitchQ, slot;
    if (gdn) {
        pW = ws + WS_WPK + ((size_t)(b * NCHK) * 8 + h) * 16384; sW = 8 * 16384;
        pQ = ws + WS_DQ + ((size_t)(b * SEQ) * 1024 + h * 128) * 2; pK = ws + WS_DK + ((size_t)(b * SEQ) * 1024 + h * 128) * 2; pitchQ = 2048; sQ = 64 * 2048;
        pU = ws + WS_DV + ((size_t)(b * SEQ) * 1024 + h * 128) * 2;
        pA = ws + WS_ATTD + ((size_t)(b * NCHK) * 8 + h) * 8192; sA = 8 * 8192; slot = h;
    } else {
        pW = nullptr; sW = 0;
        pQ = ws + WS_AQ + ((size_t)(b * SEQ) * 512 + h * 128) * 2; pK = ws + WS_AK + ((size_t)(b * SEQ) * 512 + h * 128) * 2; pitchQ = 1024; sQ = 64 * 1024;
        pU = ws + WS_AV + ((size_t)(b * SEQ) * 1024 + h * 256 + g * 128) * 2;
        pA = ws + WS_ATTA + ((size_t)(b * NCHK) * 4 + h) * 8192; sA = 4 * 8192; slot = 8 + h;
    }
    const size_t sU = 64 * 2048, sD = 12 * 512;
    pD = ws + WS_DEC + ((size_t)(b * NCHK) * 12 + slot) * 512;
    float* ssb = (float*)(ws + WS_SSP) + (size_t)(b * SEQ) * 128 + (gdn ? h * 8 : 64 + h * 16 + g * 8) + s;

    v4u rw[2], rqd[2], rk[2], ra, rd; v2u un[4];
    const v4u z4 = {0u, 0u, 0u, 0u};
    rw[0] = z4; rw[1] = z4; rd = z4;
#define SC_LOAD(n) do { \
        if (gdn) { rw[0] = *(const v4u*)(pW + (size_t)(n) * sW + tid * 16); rw[1] = *(const v4u*)(pW + (size_t)(n) * sW + (tid + 512) * 16); } \
        _Pragma("unroll") for (int e_ = 0; e_ < 2; ++e_) { const int i_ = tid + 512 * e_; \
            rqd[e_] = *(const v4u*)(pQ + (size_t)(n) * sQ + (size_t)(i_ >> 4) * pitchQ + (i_ & 15) * 16); \
            rk[e_] = *(const v4u*)(pK + (size_t)(n) * sQ + (size_t)(i_ >> 4) * pitchQ + (i_ & 15) * 16); } \
        ra = *(const v4u*)(pA + (size_t)(n) * sA + tid * 16); \
        if (tid < 32) rd = *(const v4u*)(pD + (size_t)(n) * sD + tid * 16); \
        _Pragma("unroll") for (int mt_ = 0; mt_ < 4; ++mt_) un[mt_] = *(const v2u*)(pU + (size_t)(n) * sU + (size_t)((s * 4 + mt_) * 2 + (lane >> 5)) * 2048 + (lane & 31) * 8); \
    } while (0)
#define SC_STORE(buf) do { LAS uchar* l_ = lds + (buf) * SC_BUF; \
        *(LAS v4u*)(l_ + tid * 16) = rw[0]; *(LAS v4u*)(l_ + (tid + 512) * 16) = rw[1]; \
        *(LAS v4u*)(l_ + 16384 + tid * 16) = rqd[0]; *(LAS v4u*)(l_ + 16384 + (tid + 512) * 16) = rqd[1]; \
        *(LAS v4u*)(l_ + 32768 + tid * 16) = rk[0]; *(LAS v4u*)(l_ + 32768 + (tid + 512) * 16) = rk[1]; \
        *(LAS v4u*)(l_ + 49152 + tid * 16) = ra; \
        if (tid < 32) *(LAS v4u*)(l_ + 57344 + tid * 16) = rd; \
    } while (0)

    f32x4 S[8];
#pragma unroll
    for (int i = 0; i < 8; ++i) S[i] = (f32x4){0.f, 0.f, 0.f, 0.f};
    SC_LOAD(0);
    SC_STORE(0);
    f32x4 u[4];
#pragma unroll
    for (int mt = 0; mt < 4; ++mt) u[mt] = (f32x4){bflo(un[mt].x), bfhi(un[mt].x), bflo(un[mt].y), bfhi(un[mt].y)};
    asm volatile("s_waitcnt vmcnt(0)" ::: "memory");
    __syncthreads();
    for (int n = 0; n < NCHK; ++n) {
        if (n + 1 < NCHK) SC_LOAD(n + 1);
        const LAS uchar* L = lds + (n & 1) * SC_BUF;
        bf16x8 Sb[4];
#pragma unroll
        for (int kt = 0; kt < 4; ++kt) Sb[kt] = pack8(S[2 * kt], S[2 * kt + 1]);
        f32x4 vn[4];
        if (gdn) {
#pragma unroll
            for (int mt = 0; mt < 4; ++mt) { f32x4 acc = u[mt];
#pragma unroll
                for (int kt = 0; kt < 4; ++kt) acc = MFMA16(*(const LAS bf16x8*)(L + ((mt * 4 + kt) * 64 + lane) * 16), Sb[kt], acc);
                vn[mt] = acc; }
        } else {
#pragma unroll
            for (int mt = 0; mt < 4; ++mt) vn[mt] = u[mt];
        }
        bf16x8 vb[2]; vb[0] = pack8(vn[0], vn[1]); vb[1] = pack8(vn[2], vn[3]);
        f32x4 o[4];
#pragma unroll
        for (int mt = 0; mt < 4; ++mt) { f32x4 acc = {0.f, 0.f, 0.f, 0.f};
#pragma unroll
            for (int kt = 0; kt < 4; ++kt) acc = MFMA16(*(const LAS bf16x8*)(L + 16384 + ((mt * 4 + kt) * 64 + lane) * 16), Sb[kt], acc);
#pragma unroll
            for (int k2 = 0; k2 < 2; ++k2) acc = MFMA16(*(const LAS bf16x8*)(L + 49152 + ((mt * 2 + k2) * 64 + lane) * 16), vb[k2], acc);
            o[mt] = acc; }
#pragma unroll
        for (int m8 = 0; m8 < 8; ++m8) { const f32x4 dv = *(const LAS f32x4*)(L + 57344 + (16 * m8 + 4 * rq) * 4);
            f32x4 acc = S[m8] * dv;
#pragma unroll
            for (int k2 = 0; k2 < 2; ++k2) acc = MFMA16(*(const LAS bf16x8*)(L + 32768 + ((m8 * 2 + k2) * 64 + lane) * 16), vb[k2], acc);
            S[m8] = acc; }
        {
            uchar* ob = pU + (size_t)n * sU + (16 * s + c) * 2; float* ssn = ssb + (size_t)(n * 64) * 128;
#pragma unroll
            for (int mt = 0; mt < 4; ++mt)
#pragma unroll
                for (int j = 0; j < 4; ++j) { const int row = 16 * mt + 4 * rq + j; const float ov = o[mt][j];
                    *(bf16*)(ob + (size_t)row * 2048) = (bf16)f2bf(ov);
                    float q = ov * ov; q += __shfl_xor(q, 1); q += __shfl_xor(q, 2); q += __shfl_xor(q, 4); q += __shfl_xor(q, 8);
                    if (c == 0) ssn[row * 128] = q; }
        }
        if (n + 1 < NCHK) {
            SC_STORE((n + 1) & 1);
#pragma unroll
            for (int mt = 0; mt < 4; ++mt) u[mt] = (f32x4){bflo(un[mt].x), bfhi(un[mt].x), bflo(un[mt].y), bfhi(un[mt].y)};
        }
        asm volatile("s_waitcnt vmcnt(0)" ::: "memory");
        __syncthreads();
    }
#undef SC_LOAD
#undef SC_STORE
}

#ifndef DBG_BRD_A
#define DBG_BRD_A WS_DV
#endif
#ifndef DBG_BRD_B
#define DBG_BRD_B WS_WBD
#endif
__global__ void __launch_bounds__(512, 2) mega_fwd(Params P) {
    extern __shared__ __attribute__((aligned(16))) unsigned char shm[];
    LAS uchar* lds = (LAS uchar*)shm;
    cg::grid_group grid = cg::this_grid();
    uchar* ws = P.ws;
    const int lo = P.lo, hi = P.hi;
#ifndef PH_MASK
#define PH_MASK 0x3fff
#endif
#define IN(k) (((PH_MASK >> (k)) & 1) && lo <= (k) && (k) < hi)
#define SEAM(k) do { if (IN(k) && IN((k) + 1)) grid.sync(); } while (0)
    if (IN(0)) { phase0(P, lds); } SEAM(0);
    if (IN(1)) { phase_norm1(P); } SEAM(1);
    if (IN(2)) { run_gemm<M_INPROJ>(lds, (const bf16*)(ws + WS_HB), (const bf16*)(ws + WS_WIN), WIN1_ROWS, 1024, ws, nullptr, nullptr); } SEAM(2);
    if (IN(3)) {
#ifndef PREP_MASK
#define PREP_MASK 3
#endif
        if (PREP_MASK & 1) for (int it = blockIdx.x; it < 4096; it += gridDim.x) prep_gdn(P, lds, it);
        if (PREP_MASK & 2) for (int it = blockIdx.x; it < 2048; it += gridDim.x) prep_gla(P, lds, it);
    } SEAM(3);
    if (IN(4)) { phase_scan(P, lds); } SEAM(4);
    if (IN(5)) { phase_norm1(P); } SEAM(5);
    if (IN(6)) { run_gemm<M_GATES>(lds, (const bf16*)(ws + WS_HB), (const bf16*)(ws + WS_WIN) + (size_t)WIN1_ROWS * 1024, WIN2_ROWS, 1024, ws, P.in[11], P.in[15]); } SEAM(6);
    if (IN(7)) { run_gemm<M_BRA>(lds, (const bf16*)(ws + WS_AV), (const bf16*)(ws + WS_WBG), 1024, 1024, ws, nullptr, nullptr); } SEAM(7);
    if (IN(8)) { run_gemm<M_BRD>(lds, (const bf16*)(ws + DBG_BRD_A), (const bf16*)(ws + DBG_BRD_B), 1024, 1024, ws, nullptr, nullptr); } SEAM(8);
    if (IN(9)) { run_gemm<M_OUT>(lds, (const bf16*)(ws + WS_MG), (const bf16*)(ws + WS_WOUT), 1024, 1024, ws, nullptr, nullptr); } SEAM(9);
    if (IN(10)) { phase_row1(P); } SEAM(10);
    if (IN(11)) { run_gemm<M_MLP1>(lds, (const bf16*)(ws + WS_H2), (const bf16*)(ws + WS_W1), 4096, 1024, ws, nullptr, nullptr); } SEAM(11);
    if (IN(12)) { run_gemm<M_MLP2>(lds, (const bf16*)(ws + WS_A1), (const bf16*)(ws + WS_W2), 1024, 4096, ws, nullptr, nullptr); } SEAM(12);
    if (IN(13)) { phase_row2(P); }
#undef IN
#undef SEAM
}

#ifdef DBG_STOP
__global__ void __launch_bounds__(256) dbg_dump(const bf16* src, float* out) {
    for (size_t i = (size_t)blockIdx.x * 256 + threadIdx.x; i < (size_t)T * 1024; i += (size_t)gridDim.x * 256) { unsigned hsh = ((unsigned)src[i] + 1u) * 2654435761u; hsh ^= hsh >> 15; hsh *= 2246822519u; out[i] = (float)(hsh >> 8) * (1.0f / 16777216.0f); }
}
#endif
#ifndef N_LAUNCH_MODE
#define N_LAUNCH_MODE 1
#endif
extern "C" void kernel_launch(void* const* d_in, const int* in_sizes, int n_in, void* d_out, int out_size, void* d_ws, size_t ws_size, hipStream_t stream) {
    static int grid_blocks = 0;
    if (!grid_blocks) {
        int dev = 0, cus = 0, per_cu = 0;
        hipGetDevice(&dev);
        hipDeviceGetAttribute(&cus, hipDeviceAttributeMultiprocessorCount, dev);
        hipFuncSetAttribute((const void*)mega_fwd, hipFuncAttributeMaxDynamicSharedMemorySize, LDS_BYTES);
        hipOccupancyMaxActiveBlocksPerMultiprocessor(&per_cu, (const void*)mega_fwd, 512, LDS_BYTES);
        if (per_cu < 1) { fprintf(stderr, "kernel_launch: occupancy query gives %d blocks per CU\n", per_cu); per_cu = 1; }
        grid_blocks = cus * per_cu;
        if (grid_blocks > 256) grid_blocks = 256;
        if (n_in != 21 || ws_size < WS_END) fprintf(stderr, "kernel_launch: unexpected n_in %d or ws_size %zu (< %zu)\n", n_in, ws_size, (size_t)WS_END);
    }
    Params p{};
    for (int i = 0; i < 21; ++i) p.in[i] = (const float*)d_in[i];
    p.out = (float*)d_out; p.ws = (uchar*)d_ws;
    if (N_LAUNCH_MODE == 1) {
        p.lo = 0; p.hi = NPHASE;
        void* args[] = {&p};
        hipError_t e = hipLaunchCooperativeKernel((const void*)mega_fwd, dim3(grid_blocks), dim3(512), args, LDS_BYTES, stream);
        if (e != hipSuccess) fprintf(stderr, "cooperative launch failed: %s (grid %d)\n", hipGetErrorString(e), grid_blocks);
    } else {
#ifdef DBG_STOP
        for (int k = 0; k <= DBG_STOP; ++k) { p.lo = k; p.hi = k + 1; hipLaunchKernelGGL(mega_fwd, dim3(grid_blocks), dim3(512), LDS_BYTES, stream, p); }
        hipLaunchKernelGGL(dbg_dump, dim3(2048), dim3(256), 0, stream, (const bf16*)((uchar*)d_ws + (size_t)DBG_SRC * MiB), (float*)d_out);
#else
        for (int k = 0; k < NPHASE; ++k) { p.lo = k; p.hi = k + 1; hipLaunchKernelGGL(mega_fwd, dim3(grid_blocks), dim3(512), LDS_BYTES, stream, p); }
#endif
    }
}
```

```cpp
#include <hip/hip_runtime.h>
#include <hip/hip_cooperative_groups.h>
#include <cstdio>
#include <cstdint>
namespace cg = cooperative_groups;
namespace pg8 {
#define PG8_LAS __attribute__((address_space(3)))
typedef unsigned short bf16_t;
typedef short bf16x8 __attribute__((ext_vector_type(8)));
typedef float f32x4 __attribute__((ext_vector_type(4)));
typedef unsigned u32x4 __attribute__((ext_vector_type(4)));
constexpr int BM = 256, BK = 64, HALF = 128, HTB = HALF * BK * 2  , STAGE_BYTES = 8 * HTB, NXCD = 8, WGM = 8;

__host__ __device__ __forceinline__ int lds_byte(int r, int c) { const int st = (r >> 4) * 2 + (c >> 5), rr = r & 15, cc = c & 31, ob = rr * 64 + cc * 2; return st * 1024 + (ob ^ (((ob >> 9) & 1) << 5)); }
__host__ __device__ __forceinline__ void stage_rc(int b, int& R, int& C) { const int st = b / 1024, sb = b % 1024, swz = sb ^ (((sb >> 9) & 1) << 5); R = (st >> 1) * 16 + swz / 64; C = (st & 1) * 32 + (swz % 64) / 2; }
__host__ __device__ __forceinline__ int perm32(int rho) { const int n = rho >> 4, i = rho & 15; return 8 * (i >> 2) + 4 * n + (i & 3); }

struct Unit { int pm, pn; };
struct Gemm { const bf16_t* A; const bf16_t* Bt; int M, N, K; };

struct StaticOrder {
    int nM, nN, nwg, G, c;
    __host__ __device__ void init(int M, int N, int G_, int c_) { nM = M / BM; nN = N / BM; nwg = nM * nN; G = G_; c = c_; }
    __host__ __device__ bool next(int i, Unit& u) const {
        const long L = (long)i * G + c; if (L >= nwg) return false;
        int wgid = (int)L; { const int q = nwg / NXCD, r = nwg % NXCD, xcd = wgid % NXCD, off = wgid / NXCD; wgid = (xcd < r ? xcd * (q + 1) : r * (q + 1) + (xcd - r) * q) + off; }
        const int nig = WGM * nN, gid = wgid / nig, fm = gid * WGM, gsz = (nM - fm) < WGM ? (nM - fm) : WGM;
        u.pm = fm + ((wgid % nig) % gsz); u.pn = (wgid % nig) / gsz; return true;
    }
    __device__ __forceinline__ void a_ready(const Unit&) const {}
    __device__ __forceinline__ void done(const Unit&) const {}
};
__device__ __forceinline__ unsigned cvt_pk_bf16(float lo, float hi) { unsigned r; asm volatile("v_cvt_pk_bf16_f32 %0, %1, %2" : "=v"(r) : "v"(lo), "v"(hi)); return r; }
template <class Epi, class Sched, bool ALIGN_EPI = false, bool SP2 = false>
__device__ __forceinline__ void gemm_phase(PG8_LAS unsigned char* lds, const Gemm g, const Sched& S, const Epi& E) {
    const int tid = threadIdx.x, wid = __builtin_amdgcn_readfirstlane(tid >> 6), lane = tid & 63, wr = wid >> 2, wc = wid & 3, fr = lane & 15, fq = lane >> 4;
    const int K = g.K, nt = K / BK;
    unsigned voffA[2], voffB[2];
#pragma unroll
    for (int i = 0; i < 2; ++i) { int R, C; stage_rc(tid * 16 + i * 8192, R, C); const int Rb = Epi::PERM ? ((R & ~31) + perm32(R & 31)) : R;
        voffA[i] = (unsigned)(R * K + C) * 2u; voffB[i] = (unsigned)(Rb * K + C) * 2u; }
    const size_t kstep = (size_t)(BK * 2);
    const size_t hstep = (size_t)HALF * K * 2;
    const size_t tstep = 2 * hstep;
    const unsigned ldsw = (unsigned)wid * 1024u;
    const int aoff = lds_byte(wr * 64 + fr, fq * 8), boff = lds_byte(wc * 32 + fr, fq * 8);
#define PG8_SA(b, h) (((b) * 2 + (h)) * HTB)
#define PG8_SB(b, h) ((4 + (b) * 2 + (h)) * HTB)
#define PG8_STAGE(bufoff, gbase, voff) do { _Pragma("unroll") for (int _i = 0; _i < 2; ++_i) \
        __builtin_amdgcn_global_load_lds((const unsigned*)((const char*)(gbase) + (voff)[_i]), (PG8_LAS unsigned*)(lds + (bufoff) + ldsw + _i * 8192), 16, 0, 0); } while (0)
#define PG8_LDA(dst, b, h) do { _Pragma("unroll") for (int m = 0; m < 4; ++m) _Pragma("unroll") for (int k = 0; k < 2; ++k) dst[m][k] = *(const PG8_LAS bf16x8*)(lds + PG8_SA(b, h) + aoff + m * 2048 + k * 1024); } while (0)
#define PG8_LDB(dst, b, h) do { _Pragma("unroll") for (int n = 0; n < 2; ++n) _Pragma("unroll") for (int k = 0; k < 2; ++k) dst[n][k] = *(const PG8_LAS bf16x8*)(lds + PG8_SB(b, h) + boff + n * 2048 + k * 1024); } while (0)
#define PG8_MMA(ai, bj, At, Bt) do { __builtin_amdgcn_s_setprio(1); _Pragma("unroll") for (int m = 0; m < 4; ++m) _Pragma("unroll") for (int n = 0; n < 2; ++n) _Pragma("unroll") for (int k = 0; k < 2; ++k) \
        acc[ai][bj][m][n] = __builtin_amdgcn_mfma_f32_16x16x32_bf16(Bt[n][k], At[m][k], acc[ai][bj][m][n], 0, 0, 0); __builtin_amdgcn_s_setprio(0); } while (0)
#define PG8_WAIT_V(n) asm volatile("s_waitcnt vmcnt(" #n ")" ::: "memory")
#define PG8_WAIT_L(n) asm volatile("s_waitcnt lgkmcnt(" #n ")" ::: "memory")
#define PG8_BAR __builtin_amdgcn_s_barrier()
#define PG8_SCHED __builtin_amdgcn_sched_barrier(0)
    Unit cur, nxt; int ui = 0;
    if (!S.next(0, cur)) return;
    f32x4 acc[2][2][4][2];
#pragma unroll
    for (int a = 0; a < 2; ++a)
#pragma unroll
        for (int b = 0; b < 2; ++b)
#pragma unroll
            for (int m = 0; m < 4; ++m)
#pragma unroll
                for (int n = 0; n < 2; ++n) acc[a][b][m][n] = (f32x4){0.f, 0.f, 0.f, 0.f};
    bf16x8 At[4][2], B0[2][2], B1[2][2];
    const char* cA = (const char*)g.A + (size_t)cur.pm * tstep; const char* cB = (const char*)g.Bt + (size_t)cur.pn * tstep;
    S.a_ready(cur);
    if constexpr (SP2) {
        PG8_STAGE(PG8_SB(0, 0), cB, voffB); PG8_STAGE(PG8_SB(0, 1), cB + hstep, voffB); PG8_STAGE(PG8_SA(0, 0), cA, voffA); PG8_STAGE(PG8_SA(0, 1), cA + hstep, voffA);
        if (wr == 1) PG8_BAR;
        PG8_WAIT_V(2); PG8_BAR;
        PG8_STAGE(PG8_SB(1, 0), cB + kstep, voffB); PG8_STAGE(PG8_SA(1, 0), cA + kstep, voffA); PG8_STAGE(PG8_SB(1, 1), cB + hstep + kstep, voffB);
        PG8_WAIT_V(6); PG8_BAR;
    } else {
        PG8_STAGE(PG8_SB(0, 0), cB, voffB); PG8_STAGE(PG8_SA(0, 0), cA, voffA); PG8_STAGE(PG8_SB(0, 1), cB + hstep, voffB); PG8_STAGE(PG8_SA(0, 1), cA + hstep, voffA);
        if (wr == 1) PG8_BAR;
        PG8_WAIT_V(4); PG8_BAR;
        PG8_STAGE(PG8_SB(1, 0), cB + kstep, voffB); PG8_STAGE(PG8_SA(1, 0), cA + kstep, voffA); PG8_STAGE(PG8_SB(1, 1), cB + hstep + kstep, voffB);
        PG8_WAIT_V(6); PG8_BAR;
    }
    for (;;) {
        const bool has_next = S.next(ui + 1, nxt);
        const char* nA = has_next ? (const char*)g.A + (size_t)nxt.pm * tstep : cA; const char* nB = has_next ? (const char*)g.Bt + (size_t)nxt.pn * tstep : cB;
        for (int t = 0; t < nt; t += 2) {
            const bool last = (t == nt - 2);
            const char* a1 = cA + (size_t)(t + 1) * kstep;
            const char* a2 = last ? nA : cA + (size_t)(t + 2) * kstep; const char* b2 = last ? nB : cB + (size_t)(t + 2) * kstep;
            const char* a3 = a2 + kstep; const char* b3 = b2 + kstep;
            if (last && has_next) S.a_ready(nxt);
            if constexpr (SP2) {
            PG8_LDB(B0, 0, 0); PG8_LDB(B1, 0, 1); PG8_SCHED; PG8_LDA(At, 0, 0); PG8_STAGE(PG8_SA(1, 1), a1 + hstep, voffA);
            PG8_WAIT_V(8); PG8_WAIT_L(0); PG8_BAR; PG8_MMA(0, 0, At, B0); PG8_MMA(0, 1, At, B1); PG8_BAR; PG8_SCHED;
            PG8_LDA(At, 0, 1); PG8_STAGE(PG8_SB(0, 0), b2, voffB); PG8_STAGE(PG8_SB(0, 1), b2 + hstep, voffB); PG8_STAGE(PG8_SA(0, 0), a2, voffA);
            PG8_WAIT_V(8); PG8_WAIT_L(0); PG8_BAR; PG8_MMA(1, 0, At, B0); PG8_MMA(1, 1, At, B1); PG8_BAR; PG8_SCHED;
            PG8_LDB(B0, 1, 0); PG8_LDB(B1, 1, 1); PG8_SCHED; PG8_LDA(At, 1, 0); PG8_STAGE(PG8_SA(0, 1), a2 + hstep, voffA);
            PG8_WAIT_V(8); PG8_WAIT_L(0); PG8_BAR; PG8_MMA(0, 0, At, B0); PG8_MMA(0, 1, At, B1); PG8_BAR; PG8_SCHED;
            PG8_LDA(At, 1, 1); PG8_STAGE(PG8_SB(1, 0), b3, voffB); PG8_STAGE(PG8_SB(1, 1), b3 + hstep, voffB); PG8_STAGE(PG8_SA(1, 0), a3, voffA);
            PG8_WAIT_V(8); PG8_WAIT_L(0); PG8_BAR; PG8_MMA(1, 0, At, B0); PG8_MMA(1, 1, At, B1); PG8_BAR; PG8_SCHED;
            } else {
            PG8_LDB(B0, 0, 0); PG8_SCHED; PG8_LDA(At, 0, 0); PG8_STAGE(PG8_SA(1, 1), a1 + hstep, voffA);
            PG8_WAIT_L(8); PG8_BAR; PG8_WAIT_L(0); PG8_MMA(0, 0, At, B0); PG8_BAR; PG8_SCHED;
            PG8_LDB(B1, 0, 1); PG8_STAGE(PG8_SB(0, 0), b2, voffB);
            PG8_BAR; PG8_WAIT_L(0); PG8_MMA(0, 1, At, B1); PG8_BAR;
            PG8_LDA(At, 0, 1); PG8_STAGE(PG8_SA(0, 0), a2, voffA);
            PG8_BAR; PG8_WAIT_L(0); PG8_MMA(1, 0, At, B0); PG8_BAR; PG8_SCHED;
            PG8_STAGE(PG8_SB(0, 1), b2 + hstep, voffB);
            PG8_WAIT_V(6); PG8_BAR; PG8_MMA(1, 1, At, B1); PG8_BAR;
            PG8_LDB(B0, 1, 0); PG8_SCHED; PG8_LDA(At, 1, 0); PG8_STAGE(PG8_SA(0, 1), a2 + hstep, voffA);
            PG8_WAIT_L(8); PG8_BAR; PG8_WAIT_L(0); PG8_MMA(0, 0, At, B0); PG8_BAR; PG8_SCHED;
            PG8_LDB(B1, 1, 1); PG8_STAGE(PG8_SB(1, 0), b3, voffB);
            PG8_BAR; PG8_WAIT_L(0); PG8_MMA(0, 1, At, B1); PG8_BAR;
            PG8_LDA(At, 1, 1); PG8_STAGE(PG8_SA(1, 0), a3, voffA);
            PG8_BAR; PG8_WAIT_L(0); PG8_MMA(1, 0, At, B0); PG8_BAR; PG8_SCHED;
            PG8_STAGE(PG8_SB(1, 1), b3 + hstep, voffB);
            PG8_WAIT_V(6); PG8_BAR; PG8_MMA(1, 1, At, B1); PG8_BAR;
            }
        }
        if constexpr (ALIGN_EPI) { if (wr == 0) PG8_BAR; }
        if constexpr (!Epi::AFTER_DRAIN) { E(acc, cur, wr, wc, fr, fq); S.done(cur); }
        if (!has_next) break;
#pragma unroll
        for (int a = 0; a < 2; ++a)
#pragma unroll
            for (int b = 0; b < 2; ++b)
#pragma unroll
                for (int m = 0; m < 4; ++m)
#pragma unroll
                    for (int n = 0; n < 2; ++n) acc[a][b][m][n] = (f32x4){0.f, 0.f, 0.f, 0.f};
        cur = nxt; cA = nA; cB = nB; ++ui;
        if constexpr (ALIGN_EPI) { if (wr == 1) PG8_BAR; }
    }
    PG8_WAIT_V(0);
    if constexpr (!ALIGN_EPI) { if (wr == 0) PG8_BAR; }
    PG8_BAR;
    if constexpr (Epi::AFTER_DRAIN) { E.fused(acc, cur, wr, wc, fr, fq, lds, wid, lane); S.done(cur); }
#undef PG8_SA
#undef PG8_SB
#undef PG8_STAGE
#undef PG8_LDA
#undef PG8_LDB
#undef PG8_MMA
#undef PG8_WAIT_V
#undef PG8_WAIT_L
#undef PG8_BAR
#undef PG8_SCHED
}
}

#define LAS __attribute__((address_space(3)))
typedef unsigned short bf16;
typedef unsigned char uchar;
typedef unsigned v4u __attribute__((ext_vector_type(4)));
typedef unsigned v2u __attribute__((ext_vector_type(2)));
typedef float f32x4 __attribute__((ext_vector_type(4)));
typedef short bf16x8 __attribute__((ext_vector_type(8)));
#define MFMA16(a, b, c) __builtin_amdgcn_mfma_f32_16x16x32_bf16((a), (b), (c), 0, 0, 0)

constexpr int T = 32768, DM = 1024, SEQ = 16384, NCHK = 256;
constexpr float EPS = 1e-6f;
constexpr size_t MiB = 1u << 20;
constexpr size_t WS_PROG = 65536;
constexpr size_t WS_MOD = 0, WS_SS = 1 * MiB, WS_DEC = 3 * MiB, WS_SM = 6 * MiB, WS_HALO = 10 * MiB;
constexpr size_t WS_WIN = 20 * MiB, WS_WBG = 39 * MiB, WS_WBD = 41 * MiB, WS_WOUT = 43 * MiB, WS_W1 = 45 * MiB, WS_W2 = 53 * MiB;
constexpr size_t WS_WPK = 64 * MiB;
constexpr size_t WS_HB = 64 * MiB, WS_AQ = 128 * MiB, WS_AK = 160 * MiB, WS_AV = 192 * MiB, WS_DQ = 256 * MiB, WS_DK = 320 * MiB, WS_DV = 384 * MiB;
constexpr size_t WS_ATTD = 448 * MiB, WS_ATTA = 480 * MiB, WS_SSP = 496 * MiB, WS_END = 512 * MiB;
constexpr size_t WS_SGA = 128 * MiB, WS_SGD = 256 * MiB, WS_YA = 320 * MiB, WS_MG = 128 * MiB, WS_Z = 256 * MiB, WS_H2 = 64 * MiB, WS_A1 = 128 * MiB, WS_Y = 384 * MiB;
constexpr int WIN1_ROWS = 5376, WIN2_ROWS = 4096;
constexpr int LDS_BYTES = 163840;
constexpr int NPHASE = 14;

struct Params { const float* in[21]; float* out; uchar* ws; int lo, hi; };

__device__ __forceinline__ unsigned f2bf(float f) { unsigned u = __float_as_uint(f); return (u + 0x7fffu + ((u >> 16) & 1u)) >> 16; }
typedef float f32x2_ __attribute__((ext_vector_type(2)));
typedef __bf16 bf16x2_ __attribute__((ext_vector_type(2)));
__device__ __forceinline__ unsigned pk2(float lo, float hi) { const f32x2_ v = {lo, hi}; return __builtin_bit_cast(unsigned, __builtin_convertvector(v, bf16x2_)); }
__device__ __forceinline__ float bf2f(unsigned b) { return __uint_as_float(b << 16); }
__device__ __forceinline__ float bflo(unsigned w) { return __uint_as_float(w << 16); }
__device__ __forceinline__ float bfhi(unsigned w) { return __uint_as_float(w & 0xffff0000u); }
__device__ __forceinline__ bf16x8 pack8(f32x4 a, f32x4 b) { v4u p; p.x = pk2(a[0], a[1]); p.y = pk2(a[2], a[3]); p.z = pk2(b[0], b[1]); p.w = pk2(b[2], b[3]); return __builtin_bit_cast(bf16x8, p); }
__device__ __forceinline__ float wave_sum(float v) {
#pragma unroll
    for (int o = 1; o < 64; o <<= 1) v += __shfl_xor(v, o);
    return v;
}
__device__ __forceinline__ float sigmoidf_(float x) { return 1.0f / (1.0f + __expf(-x)); }
__device__ __forceinline__ float siluf_(float x) { return x / (1.0f + __expf(-x)); }
__device__ __forceinline__ float softplusf_(float x) { return fmaxf(x, 0.f) + log1pf(__expf(-fabsf(x))); }

__device__ __forceinline__ int win_dest_row(int j) {
    if (j < 2048) return j;
    if (j < 3072) return WIN1_ROWS + (j - 2048);
    if (j < 3088) return 5120 + (j - 3072);
    if (j < 6160) return 2048 + (j - 3088);
    if (j < 7184) return WIN1_ROWS + 1024 + (j - 6160);
    if (j < 7200) return 5136 + (j - 7184);
    return WIN1_ROWS + 2048 + (j - 7200);
}
template <bool REMAP>
__device__ __forceinline__ void tr_item(const float* W, int K, int N, bf16* WT, LAS float* scr, int item, int lane) {
    const int nblk = N / 32, kb = item / nblk, nb = item % nblk, k0 = 64 * kb, n0 = 32 * nb;
#pragma unroll 8
    for (int i = 0; i < 32; ++i) { const int kk = 2 * i + (lane >> 5); scr[kk * 33 + (lane & 31)] = W[(size_t)(k0 + kk) * N + n0 + (lane & 31)]; }
    asm volatile("s_waitcnt lgkmcnt(0)" ::: "memory");
    const int c = lane & 7;
#pragma unroll
    for (int j = 0; j < 4; ++j) { const int n = (lane >> 3) + 8 * j; const LAS float* s = scr + (8 * c) * 33 + n;
        v4u o; o.x = pk2(s[0 * 33], s[1 * 33]); o.y = pk2(s[2 * 33], s[3 * 33]); o.z = pk2(s[4 * 33], s[5 * 33]); o.w = pk2(s[6 * 33], s[7 * 33]);
        const int dr = REMAP ? win_dest_row(n0 + n) : (n0 + n);
        *(v4u*)(WT + (size_t)dr * K + k0 + 8 * c) = o; }
    asm volatile("s_waitcnt lgkmcnt(0)" ::: "memory");
}
__device__ __forceinline__ void phase0(const Params& P, LAS uchar* lds) {
    const int tid = threadIdx.x, lane = tid & 63, wave = tid >> 6;
    const int gw = blockIdx.x * 8 + wave, NGW = gridDim.x * 8;
    LAS float* scr = (LAS float*)(lds + wave * 16384);
    uchar* ws = P.ws;
    constexpr int I_IN = 16 * 289, I_SQ = 16 * 32, I_1 = 16 * 128, I_2 = 64 * 32;
    constexpr int NITEMS = I_IN + 3 * I_SQ + I_1 + I_2;
    for (int it = gw; it < NITEMS; it += NGW) {
        int r = it;
        if (r < I_IN) { tr_item<true>(P.in[8], 1024, 9248, (bf16*)(ws + WS_WIN), scr, r, lane); continue; } r -= I_IN;
        if (r < I_SQ) { tr_item<false>(P.in[16], 1024, 1024, (bf16*)(ws + WS_WBG), scr, r, lane); continue; } r -= I_SQ;
        if (r < I_SQ) { tr_item<false>(P.in[17], 1024, 1024, (bf16*)(ws + WS_WBD), scr, r, lane); continue; } r -= I_SQ;
        if (r < I_SQ) { tr_item<false>(P.in[18], 1024, 1024, (bf16*)(ws + WS_WOUT), scr, r, lane); continue; } r -= I_SQ;
        if (r < I_1) { tr_item<false>(P.in[19], 1024, 4096, (bf16*)(ws + WS_W1), scr, r, lane); continue; } r -= I_1;
        tr_item<false>(P.in[20], 4096, 1024, (bf16*)(ws + WS_W2), scr, r, lane);
    }
    if (blockIdx.x == 0 && tid < 64) ((unsigned*)(ws + WS_PROG))[tid * 64] = 0u;
    { v4u* z = (v4u*)(ws + WS_WIN + (size_t)5152 * 2048); const int n16 = 224 * 128; const v4u zz = {0u, 0u, 0u, 0u};
      for (int i = blockIdx.x * 512 + tid; i < n16; i += gridDim.x * 512) z[i] = zz; }
    float* mod = (float*)(ws + WS_MOD);
    const float* cvec = P.in[1]; const float* aw = P.in[2]; const float* ab = P.in[3];
    for (int task = gw; task < 384; task += NGW) {
        const int cq = lane & 3, rg = lane >> 2, col = task * 16 + cq * 4;
        f32x4 a0 = {0.f, 0.f, 0.f, 0.f}, a1 = {0.f, 0.f, 0.f, 0.f};
#pragma unroll 8
        for (int i = 0; i < 64; ++i) { const int k = rg + 16 * i;
            const float s0 = siluf_(cvec[k]), s1 = siluf_(cvec[1024 + k]);
            const f32x4 w = *(const f32x4*)(aw + (size_t)k * 6144 + col);
            a0 += w * s0; a1 += w * s1; }
#pragma unroll
        for (int e = 0; e < 4; ++e) {
#pragma unroll
            for (int o = 4; o < 64; o <<= 1) { a0[e] += __shfl_xor(a0[e], o); a1[e] += __shfl_xor(a1[e], o); } }
        if (rg == 0) { const f32x4 bb = *(const f32x4*)(ab + col); *(f32x4*)(mod + col) = a0 + bb; *(f32x4*)(mod + 6144 + col) = a1 + bb; }
    }
}

template <bool WITH_SS>
__device__ __forceinline__ void phase_norm1(const Params& P) {
    const int tid = threadIdx.x, lane = tid & 63, wave = tid >> 6;
    const int gw = blockIdx.x * 8 + wave, NGW = gridDim.x * 8;
    const float* x = P.in[0]; const float* w = P.in[4]; const float* mod = (const float*)(P.ws + WS_MOD);
    bf16* hb = (bf16*)(P.ws + WS_HB);
    for (int m = gw; m < T; m += NGW) {
        const int b = m / SEQ; const float* mb = mod + b * 6144;
        const f32x4* xr = (const f32x4*)(x + (size_t)m * DM) + lane;
        f32x4 v[4]; float s = 0.f;
#pragma unroll
        for (int j = 0; j < 4; ++j) { v[j] = xr[64 * j]; s += (v[j][0] * v[j][0] + v[j][1] * v[j][1]) + (v[j][2] * v[j][2] + v[j][3] * v[j][3]); }
        const float r = rsqrtf(wave_sum(s) * (1.f / DM) + EPS);
        v2u* o = (v2u*)(hb + (size_t)m * DM) + lane;
#pragma unroll
        for (int j = 0; j < 4; ++j) { const int col = 4 * (lane + 64 * j);
            const f32x4 ww = *(const f32x4*)(w + col), sc = *(const f32x4*)(mb + 1024 + col), sh = *(const f32x4*)(mb + col);
            const f32x4 y = v[j] * r * ww * (sc + 1.0f) + sh;
            v2u q; q.x = pk2(y[0], y[1]); q.y = pk2(y[2], y[3]); o[64 * j] = q; }
        if constexpr (WITH_SS) {
            const v2u* oa = (const v2u*)((const bf16*)P.out + (size_t)m * DM) + lane;
            const v2u* od = (const v2u*)((const bf16*)((const uchar*)P.out + 64 * MiB) + (size_t)m * DM) + lane;
            float* ss = (float*)(P.ws + WS_SS) + (size_t)m * 16;
#pragma unroll
            for (int j = 0; j < 4; ++j) {
                const v2u qa = oa[64 * j], qd = od[64 * j];
                const float a0 = bflo(qa.x), a1 = bfhi(qa.x), a2 = bflo(qa.y), a3 = bfhi(qa.y);
                const float d0 = bflo(qd.x), d1 = bfhi(qd.x), d2 = bflo(qd.y), d3 = bfhi(qd.y);
                float sa = (a0 * a0 + a1 * a1) + (a2 * a2 + a3 * a3), sd = (d0 * d0 + d1 * d1) + (d2 * d2 + d3 * d3);
#pragma unroll
                for (int o2 = 1; o2 < 32; o2 <<= 1) { sa += __shfl_xor(sa, o2); sd += __shfl_xor(sd, o2); }
                sa += __shfl_xor(sa, 32);
                if (lane == 0) ss[8 + j] = sa;
                if ((lane & 31) == 0) ss[2 * j + (lane >> 5)] = sd;
            }
        }
    }
}
__device__ __forceinline__ void phase_row1(const Params& P) {
    const int tid = threadIdx.x, lane = tid & 63, wave = tid >> 6;
    const int gw = blockIdx.x * 8 + wave, NGW = gridDim.x * 8;
    const float* x = P.in[0]; const float* wpost = P.in[5]; const float* wpre = P.in[6]; const float* mod = (const float*)(P.ws + WS_MOD);
    const bf16* zb = (const bf16*)(P.ws + WS_Z); bf16* h2 = (bf16*)(P.ws + WS_H2);
    for (int m = gw; m < T; m += NGW) {
        const int b = m / SEQ; const float* mb = mod + b * 6144;
        const f32x4* xr = (const f32x4*)(x + (size_t)m * DM) + lane; const v2u* zr = (const v2u*)(zb + (size_t)m * DM) + lane;
        f32x4 v[4], z[4]; float s = 0.f;
#pragma unroll
        for (int j = 0; j < 4; ++j) { v[j] = xr[64 * j]; const v2u q = zr[64 * j]; z[j] = (f32x4){bflo(q.x), bfhi(q.x), bflo(q.y), bfhi(q.y)};
            s += (z[j][0] * z[j][0] + z[j][1] * z[j][1]) + (z[j][2] * z[j][2] + z[j][3] * z[j][3]); }
        const float r1 = rsqrtf(wave_sum(s) * (1.f / DM) + EPS); float s2 = 0.f;
        f32x4* orow = (f32x4*)(P.out + (size_t)m * DM) + lane;
#pragma unroll
        for (int j = 0; j < 4; ++j) { const int col = 4 * (lane + 64 * j);
            const f32x4 ww = *(const f32x4*)(wpost + col), g1 = *(const f32x4*)(mb + 2048 + col);
            v[j] = v[j] + g1 * (z[j] * r1 * ww); orow[64 * j] = v[j];
            s2 += (v[j][0] * v[j][0] + v[j][1] * v[j][1]) + (v[j][2] * v[j][2] + v[j][3] * v[j][3]); }
        const float r2 = rsqrtf(wave_sum(s2) * (1.f / DM) + EPS);
        v2u* o = (v2u*)(h2 + (size_t)m * DM) + lane;
#pragma unroll
        for (int j = 0; j < 4; ++j) { const int col = 4 * (lane + 64 * j);
            const f32x4 ww = *(const f32x4*)(wpre + col), sc = *(const f32x4*)(mb + 4096 + col), sh = *(const f32x4*)(mb + 3072 + col);
            const f32x4 y = v[j] * r2 * ww * (sc + 1.0f) + sh;
            v2u q; q.x = pk2(y[0], y[1]); q.y = pk2(y[2], y[3]); o[64 * j] = q; }
    }
}
__device__ __forceinline__ void phase_row2(const Params& P) {
    const int tid = threadIdx.x, lane = tid & 63, wave = tid >> 6;
    const int gw = blockIdx.x * 8 + wave, NGW = gridDim.x * 8;
    const float* wpost = P.in[7]; const float* mod = (const float*)(P.ws + WS_MOD);
    const bf16* yb = (const bf16*)(P.ws + WS_Y);
    for (int m = gw; m < T; m += NGW) {
        const int b = m / SEQ; const float* mb = mod + b * 6144;
        f32x4* orow = (f32x4*)(P.out + (size_t)m * DM) + lane; const v2u* yr = (const v2u*)(yb + (size_t)m * DM) + lane;
        f32x4 v[4], z[4]; float s = 0.f;
#pragma unroll
        for (int j = 0; j < 4; ++j) { v[j] = orow[64 * j]; const v2u q = yr[64 * j]; z[j] = (f32x4){bflo(q.x), bfhi(q.x), bflo(q.y), bfhi(q.y)};
            s += (z[j][0] * z[j][0] + z[j][1] * z[j][1]) + (z[j][2] * z[j][2] + z[j][3] * z[j][3]); }
        const float r1 = rsqrtf(wave_sum(s) * (1.f / DM) + EPS);
#pragma unroll
        for (int j = 0; j < 4; ++j) { const int col = 4 * (lane + 64 * j);
            const f32x4 ww = *(const f32x4*)(wpost + col), g2 = *(const f32x4*)(mb + 5120 + col);
            orow[64 * j] = v[j] + g2 * (z[j] * r1 * ww); }
    }
}

__device__ __forceinline__ v4u pack8f(const float (&v)[8]) { v4u w; w.x = pg8::cvt_pk_bf16(v[0], v[1]); w.y = pg8::cvt_pk_bf16(v[2], v[3]); w.z = pg8::cvt_pk_bf16(v[4], v[5]); w.w = pg8::cvt_pk_bf16(v[6], v[7]); return w; }
__device__ __forceinline__ void unpack8(const v4u q, float (&o)[8]) { o[0] = bflo(q.x); o[1] = bfhi(q.x); o[2] = bflo(q.y); o[3] = bfhi(q.y); o[4] = bflo(q.z); o[5] = bfhi(q.z); o[6] = bflo(q.w); o[7] = bfhi(q.w); }
#ifndef DBG_BRD_EXPR
#define DBG_BRD_EXPR (mg[e] + g[e] * v[e])
#endif
#ifndef PG8_ALIGN
#define PG8_ALIGN true
#endif
#ifndef PG8_SP2
#define PG8_SP2 true
#endif
enum { M_INPROJ = 0, M_GATES = 1, M_BRA = 2, M_BRD = 3, M_OUT = 4, M_MLP1 = 5, M_MLP2 = 6 };
template <int MODE> struct Epi {
    static constexpr bool PERM = true, AFTER_DRAIN = false;
    uchar* ws; const float* p0; const float* p1; uchar* ob;
    __device__ __forceinline__ void operator()(const pg8::f32x4 (&acc)[2][2][4][2], const pg8::Unit& u, int wr, int wc, int fr, int fq) const {
        const int pn = u.pn;
#pragma unroll
        for (int ai = 0; ai < 2; ++ai)
#pragma unroll
            for (int m = 0; m < 4; ++m) {
                const int row = u.pm * 256 + ai * 128 + wr * 64 + m * 16 + fr;
#pragma unroll
                for (int bj = 0; bj < 2; ++bj) {
                    const int cu = bj * 128 + wc * 32 + 8 * fq;
                    const pg8::f32x4 v0 = acc[ai][bj][m][0], v1 = acc[ai][bj][m][1];
                    float v[8] = {v0[0], v0[1], v0[2], v0[3], v1[0], v1[1], v1[2], v1[3]};
                    if constexpr (MODE == M_INPROJ) {
                        if (pn < 20) {
                            bf16* base; int ld, col;
                            if (pn < 2) { base = (bf16*)(ws + WS_AQ); ld = 512; col = pn * 256 + cu; }
                            else if (pn < 4) { base = (bf16*)(ws + WS_AK); ld = 512; col = (pn - 2) * 256 + cu; }
                            else { base = (bf16*)(ws + WS_AV + (size_t)((pn - 4) >> 2) * (64 * MiB)); ld = 1024; col = ((pn - 4) & 3) * 256 + cu; }
                            const v4u w = pack8f(v);
                            *(v4u*)(base + (size_t)row * ld + col) = w;
                            if (m == 3) { if (pn >= 8 && fr >= 13) { const int chunk = row >> 6, hr = (row & 63) - 61;
                                *(v4u*)((bf16*)(ws + WS_HALO) + ((size_t)chunk * 3 + hr) * 3072 + (pn - 8) * 256 + cu) = w; } }
                        } else if (bj == 0) { if (wc == 0) { float* sm = (float*)(ws + WS_SM) + (size_t)row * 32 + 8 * fq;
                            *(pg8::f32x4*)sm = v0; *(pg8::f32x4*)(sm + 4) = v1; } }
                    } else if constexpr (MODE == M_GATES) {
                        if (pn < 8) {
                            bf16* O; int col, slot; float invd; const float* ow;
                            if (pn < 4) { O = (bf16*)ob; col = pn * 256 + cu; slot = 8 + pn; invd = 1.f / 256.f; ow = p0 + cu; }
                            else { O = (bf16*)(ob + 64 * MiB); col = (pn - 4) * 256 + cu; slot = col >> 7; invd = 1.f / 128.f; ow = p1 + (col & 127); }
                            const float ssv = ((const float*)(ws + WS_SS))[(size_t)row * 16 + slot];
                            const float r = rsqrtf(ssv * invd + EPS);
                            bf16* op = O + (size_t)row * 1024 + col;
                            float o[8]; unpack8(*(const v4u*)op, o);
                            const pg8::f32x4 w0 = *(const pg8::f32x4*)ow, w1 = *(const pg8::f32x4*)(ow + 4);
                            const float wv[8] = {w0[0], w0[1], w0[2], w0[3], w1[0], w1[1], w1[2], w1[3]};
#pragma unroll
                            for (int e = 0; e < 8; ++e) v[e] = o[e] * r * wv[e] * siluf_(v[e]);
                            *(v4u*)op = pack8f(v);
                        } else {
                            bf16* G = (bf16*)(ws + (pn < 12 ? WS_SGA : WS_SGD)); const int col = ((pn - 8) & 3) * 256 + cu;
#pragma unroll
                            for (int e = 0; e < 8; ++e) v[e] = sigmoidf_(v[e]);
                            *(v4u*)(G + (size_t)row * 1024 + col) = pack8f(v);
                        }
                    } else if constexpr (MODE == M_BRA) {
                        const size_t off = (size_t)row * 1024 + pn * 256 + cu;
                        float g[8]; unpack8(*(const v4u*)((const bf16*)(ws + WS_SGA) + off), g);
#pragma unroll
                        for (int e = 0; e < 8; ++e) v[e] = g[e] * v[e];
                        *(v4u*)((bf16*)(ws + WS_YA) + off) = pack8f(v);
                    } else if constexpr (MODE == M_BRD) {
                        const size_t off = (size_t)row * 1024 + pn * 256 + cu;
                        float g[8], mg[8]; unpack8(*(const v4u*)((const bf16*)(ws + WS_SGD) + off), g); unpack8(*(const v4u*)((const bf16*)(ws + WS_YA) + off), mg);
#pragma unroll
                        for (int e = 0; e < 8; ++e) v[e] = DBG_BRD_EXPR;
                        *(v4u*)((bf16*)(ws + WS_MG) + off) = pack8f(v);
                    } else if constexpr (MODE == M_OUT) {
                        *(v4u*)((bf16*)(ws + WS_Z) + (size_t)row * 1024 + pn * 256 + cu) = pack8f(v);
                    } else if constexpr (MODE == M_MLP1) {
#pragma unroll
                        for (int e = 0; e < 8; ++e) { const float t = fmaxf(v[e], 0.f); v[e] = t * t; }
                        *(v4u*)((bf16*)(ws + WS_A1) + (size_t)row * 4096 + pn * 256 + cu) = pack8f(v);
                    } else {
                        *(v4u*)((bf16*)(ws + WS_Y) + (size_t)row * 1024 + pn * 256 + cu) = pack8f(v);
                    }
                }
            }
    }
};
template <int MODE>
__device__ __forceinline__ void run_gemm(LAS uchar* lds, const bf16* A, const bf16* Bt, int N, int K, uchar* ws, const float* p0, const float* p1, uchar* ob = nullptr) {
    pg8::Gemm g{A, Bt, T, N, K}; pg8::StaticOrder S; S.init(T, N, (int)gridDim.x, (int)blockIdx.x);
    Epi<MODE> E{ws, p0, p1, ob};
    pg8::gemm_phase<Epi<MODE>, pg8::StaticOrder, PG8_ALIGN, PG8_SP2>((PG8_LAS unsigned char*)lds, g, S, E);
}

constexpr int LP = 136;
constexpr int PL_Q = 0, PL_K = 17408, PL_V = 34816, PL_W = 52224, PL_AM = 69632, PL_SM = 86016, PL_RAW = 86784, RAWP = 784, PL_CW = 139312;
constexpr float QSCALE = 0.08838834764831845f;

__device__ __forceinline__ uchar* reg_addr(uchar* base, int pitch, int q) { return base + (size_t)(q >> 8) * pitch + (q & 255); }

template <bool GDN>
__device__ __forceinline__ void att_frag(LAS uchar* lds, int wave, int lane, const LAS float* gc, bf16* attdst) {
    const int ntq = wave >> 1, kt2 = wave & 1, c = lane & 15, rq = lane >> 4;
    f32x4 d[2];
#pragma unroll
    for (int hh = 0; hh < 2; ++hh) {
        const int mtk = 2 * kt2 + hh; f32x4 acc = {0.f, 0.f, 0.f, 0.f};
#pragma unroll
        for (int kt = 0; kt < 4; ++kt) {
            const bf16x8 a = *(const LAS bf16x8*)(lds + PL_K + ((16 * mtk + c) * LP + 32 * kt + 8 * rq) * 2);
            const bf16x8 b = *(const LAS bf16x8*)(lds + PL_Q + ((16 * ntq + c) * LP + 32 * kt + 8 * rq) * 2);
            acc = MFMA16(a, b, acc);
        }
        const int i = 16 * ntq + c;
#pragma unroll
        for (int jj = 0; jj < 4; ++jj) { const int jp = 16 * mtk + 4 * rq + jj;
            float val = acc[jj];
            if (GDN) val *= QSCALE * __expf(gc[i] - gc[jp]);
            acc[jj] = (jp <= i) ? val : 0.f; }
        d[hh] = acc;
    }
    *(bf16x8*)(attdst + ((ntq * 2 + kt2) * 64 + lane) * 8) = pack8(d[0], d[1]);
}

__device__ __forceinline__ void prep_gdn(const Params& P, LAS uchar* lds, int item) {
    const int tid = threadIdx.x, lane = tid & 63, wave = tid >> 6;
    const int b = item >> 11, n = (item >> 3) & 255, h = item & 7;
    const int t0 = b * SEQ + n * 64;
    uchar* ws = P.ws;
    LAS float* beta = (LAS float*)(lds + PL_SM); LAS float* gc = beta + 64; LAS float* eg = beta + 128;
    {
        const bf16* halo = (const bf16*)(ws + WS_HALO);
        v4u rawv[7];
#pragma unroll
        for (int e = 0; e < 7; ++e) {
            const int p = tid + 512 * e; const int r = p / 48, pc = p - r * 48, z = pc >> 4, gq = pc & 15, ri = r - 3;
            v4u xv = {0u, 0u, 0u, 0u};
            if (p < 67 * 48) {
                if (ri >= 0) xv = *(const v4u*)((const bf16*)(ws + WS_DQ + (size_t)z * (64 * MiB)) + (size_t)(t0 + ri) * 1024 + h * 128 + gq * 8);
                else if (n > 0) xv = *(const v4u*)(halo + ((size_t)(b * NCHK + n - 1) * 3 + r) * 3072 + z * 1024 + h * 128 + gq * 8);
            }
            rawv[e] = xv;
        }
#pragma unroll
        for (int e = 0; e < 7; ++e) { const int p = tid + 512 * e; const int r = p / 48, pc = p - r * 48;
            if (p < 67 * 48) *(LAS v4u*)(lds + PL_RAW + r * RAWP + pc * 16) = rawv[e]; }
        __syncthreads();
        const LAS float* cwl = (const LAS float*)(lds + PL_CW);
#pragma unroll
        for (int e = 0; e < 6; ++e) {
            const int z = e >> 1, i = (tid >> 4) + 32 * (e & 1), gq = tid & 15;
            float y[8] = {0.f, 0.f, 0.f, 0.f, 0.f, 0.f, 0.f, 0.f};
#pragma unroll
            for (int jr = 0; jr < 4; ++jr) {
                const v4u xv = *(const LAS v4u*)(lds + PL_RAW + (i + jr) * RAWP + (z * 16 + gq) * 16);
                float xf[8]; unpack8(xv, xf);
                const f32x4 w0 = *(const LAS f32x4*)(cwl + jr * 384 + z * 128 + gq * 8), w1 = *(const LAS f32x4*)(cwl + jr * 384 + z * 128 + gq * 8 + 4);
                y[0] += w0[0] * xf[0]; y[1] += w0[1] * xf[1]; y[2] += w0[2] * xf[2]; y[3] += w0[3] * xf[3];
                y[4] += w1[0] * xf[4]; y[5] += w1[1] * xf[5]; y[6] += w1[2] * xf[6]; y[7] += w1[3] * xf[7];
            }
            float ssq = 0.f;
#pragma unroll
            for (int k = 0; k < 8; ++k) { y[k] = siluf_(y[k]); ssq += y[k] * y[k]; }
            if (z < 2) {
                ssq += __shfl_xor(ssq, 1); ssq += __shfl_xor(ssq, 2); ssq += __shfl_xor(ssq, 4); ssq += __shfl_xor(ssq, 8);
                const float r = rsqrtf(ssq + EPS);
#pragma unroll
                for (int k = 0; k < 8; ++k) y[k] *= r;
            }
            v4u o; o.x = pk2(y[0], y[1]); o.y = pk2(y[2], y[3]); o.z = pk2(y[4], y[5]); o.w = pk2(y[6], y[7]);
            *(LAS v4u*)(lds + z * 17408 + (i * LP + gq * 8) * 2) = o;
        }
    }
    if (wave == 0) {
        const float* sm = (const float*)(ws + WS_SM) + (size_t)(t0 + lane) * 32;
        const float bt = sigmoidf_(sm[16 + h]);
        float g = -__expf(P.in[13][h]) * softplusf_(sm[24 + h] + P.in[14][h]);
#pragma unroll
        for (int o = 1; o < 64; o <<= 1) { const float t = __shfl_up(g, o); if (lane >= o) g += t; }
        beta[lane] = bt; gc[lane] = g; eg[lane] = __expf(g);
    }
    __syncthreads();
    const float glast = gc[63];
    {
        const int c = lane & 15, rq = lane >> 4, mt = wave >> 1;
        LAS float* am = (LAS float*)(lds + PL_AM);
#pragma unroll
        for (int hh = 0; hh < 2; ++hh) {
            const int nt = 2 * (wave & 1) + hh; f32x4 acc = {0.f, 0.f, 0.f, 0.f};
#pragma unroll
            for (int kt = 0; kt < 4; ++kt) {
                const bf16x8 a = *(const LAS bf16x8*)(lds + PL_K + ((16 * mt + c) * LP + 32 * kt + 8 * rq) * 2);
                const bf16x8 bb = *(const LAS bf16x8*)(lds + PL_K + ((16 * nt + c) * LP + 32 * kt + 8 * rq) * 2);
                acc = MFMA16(a, bb, acc);
            }
            const int j = 16 * nt + c;
#pragma unroll
            for (int jj = 0; jj < 4; ++jj) { const int i = 16 * mt + 4 * rq + jj;
                am[i * 64 + j] = (j < i) ? beta[i] * acc[jj] * __expf(gc[i] - gc[j]) : 0.f; }
        }
        att_frag<true>(lds, wave, lane, gc, (bf16*)(ws + WS_ATTD) + ((size_t)(b * NCHK + n) * 8 + h) * 4096);
    }
    __syncthreads();
    uchar* rQ = ws + WS_DQ + ((size_t)t0 * 1024 + h * 128) * 2;
    uchar* rK = ws + WS_DK + ((size_t)t0 * 1024 + h * 128) * 2;
    uchar* rU = ws + WS_DV + ((size_t)t0 * 1024 + h * 128) * 2;
    if (tid < 256) {
        const int cc = tid; float x[64];
        const LAS bf16* colp = (const LAS bf16*)(lds + (cc < 128 ? PL_V : PL_K)) + (cc & 127);
        int vzero; asm volatile("v_mov_b32 %0, 0" : "=v"(vzero));
        const LAS float* betav = beta + vzero; const LAS float* egv = eg + vzero;
#pragma unroll
        for (int j = 0; j < 64; ++j) { float r = betav[j] * bf2f(colp[j * LP]); if (cc >= 128) r *= egv[j]; x[j] = r; }
        const LAS float* am = (const LAS float*)(lds + PL_AM) + vzero;
#pragma unroll
        for (int i = 1; i < 64; ++i) {
            float ac[4] = {x[i], 0.f, 0.f, 0.f};
#pragma unroll
            for (int j4 = 0; j4 < (i + 3) / 4; ++j4) {
                const f32x4 a = *(const LAS f32x4*)(am + i * 64 + 4 * j4);
#pragma unroll
                for (int e = 0; e < 4; ++e) if (4 * j4 + e < i) ac[e] -= a[e] * x[4 * j4 + e];
            }
            x[i] = (ac[0] + ac[1]) + (ac[2] + ac[3]);
            asm volatile("" ::: "memory");
        }
        if (cc < 128) {
            const int sl = cc >> 4, c = cc & 15;
#pragma unroll
            for (int mt = 0; mt < 4; ++mt)
#pragma unroll
                for (int rq = 0; rq < 4; ++rq) { const int r0 = 16 * mt + 4 * rq;
                    v2u o; o.x = pk2(x[r0], x[r0 + 1]); o.y = pk2(x[r0 + 2], x[r0 + 3]);
                    *(v2u*)reg_addr(rU, 2048, ((sl * 4 + mt) * 64 + rq * 16 + c) * 8) = o; }
        } else {
            LAS bf16* wl = (LAS bf16*)(lds + PL_W) + (cc - 128);
#pragma unroll
            for (int i = 0; i < 64; ++i) wl[i * LP] = (bf16)f2bf(-x[i]);
        }
    } else {
        const int t2 = tid - 256;
#pragma unroll
        for (int e = 0; e < 4; ++e) {
            const int fl = t2 + 256 * e, mt = fl >> 8, kt = (fl >> 6) & 3, r = fl & 15, kq = (fl >> 4) & 3, i = 16 * mt + r;
            const v2u a = *(const LAS v2u*)(lds + PL_Q + (i * LP + 32 * kt + 4 * kq) * 2), bq = *(const LAS v2u*)(lds + PL_Q + (i * LP + 32 * kt + 16 + 4 * kq) * 2);
            const float f = QSCALE * eg[i];
            v4u o; o.x = pk2(bflo(a.x) * f, bfhi(a.x) * f); o.y = pk2(bflo(a.y) * f, bfhi(a.y) * f); o.z = pk2(bflo(bq.x) * f, bfhi(bq.x) * f); o.w = pk2(bflo(bq.y) * f, bfhi(bq.y) * f);
            *(v4u*)reg_addr(rQ, 2048, fl * 16) = o;
        }
#pragma unroll
        for (int e = 0; e < 4; ++e) {
            const int fl = t2 + 256 * e, mt8 = fl >> 7, kt2 = (fl >> 6) & 1, r = fl & 15, kq = (fl >> 4) & 3, d = 16 * mt8 + r;
            float vv[8];
#pragma unroll
            for (int s = 0; s < 8; ++s) { const int j = 32 * kt2 + (s < 4 ? 4 * kq + s : 16 + 4 * kq + s - 4);
                vv[s] = bf2f(((const LAS bf16*)(lds + PL_K))[j * LP + d]) * __expf(glast - gc[j]); }
            v4u o; o.x = pk2(vv[0], vv[1]); o.y = pk2(vv[2], vv[3]); o.z = pk2(vv[4], vv[5]); o.w = pk2(vv[6], vv[7]);
            *(v4u*)reg_addr(rK, 2048, fl * 16) = o;
        }
        if (t2 < 128) ((float*)(ws + WS_DEC))[((size_t)(b * NCHK + n) * 12 + h) * 128 + t2] = __expf(glast);
    }
    __syncthreads();
    {
        bf16* wdst = (bf16*)(ws + WS_WPK) + ((size_t)(b * NCHK + n) * 8 + h) * 8192;
#pragma unroll
        for (int e = 0; e < 2; ++e) {
            const int fl = tid + 512 * e, mt = fl >> 8, kt = (fl >> 6) & 3, r = fl & 15, kq = (fl >> 4) & 3, i = 16 * mt + r;
            const v2u a = *(const LAS v2u*)(lds + PL_W + (i * LP + 32 * kt + 4 * kq) * 2), bq = *(const LAS v2u*)(lds + PL_W + (i * LP + 32 * kt + 16 + 4 * kq) * 2);
            v4u o; o.x = a.x; o.y = a.y; o.z = bq.x; o.w = bq.y;
            *(v4u*)(wdst + fl * 8) = o;
        }
    }
    __syncthreads();
}

constexpr int GL_V = 34816, GL_ALR = 68608, GL_BQ = 72704, GL_BL = 74752, VP = 264;
__device__ __forceinline__ void prep_gla(const Params& P, LAS uchar* lds, int item) {
    const int tid = threadIdx.x, lane = tid & 63, wave = tid >> 6;
    const int b = item >> 10, n = (item >> 2) & 255, h = item & 3;
    const int t0 = b * SEQ + n * 64;
    uchar* ws = P.ws;
    LAS float* alr = (LAS float*)(lds + GL_ALR); LAS float* bqs = (LAS float*)(lds + GL_BQ); LAS float* bl = (LAS float*)(lds + GL_BL);
    if (tid < 256) { const int i = tid >> 2, r4 = (tid & 3) * 4;
        *(LAS f32x4*)(alr + i * 16 + r4) = *(const f32x4*)((const float*)(ws + WS_SM) + (size_t)(t0 + i) * 32 + r4); }
#pragma unroll
    for (int e = 0; e < 4; ++e) { const int p = tid + 512 * e, i = p >> 5, g8 = p & 31;
        *(LAS v4u*)(lds + GL_V + (i * VP + g8 * 8) * 2) = *(const v4u*)((const bf16*)(ws + WS_AV) + (size_t)(t0 + i) * 1024 + h * 256 + g8 * 8); }
    __syncthreads();
    const int d = tid & 127, qt = tid >> 7;
    float bloc[16];
    {
        const float* wlr = P.in[9] + h * 128 + d; float wl[16];
#pragma unroll
        for (int r = 0; r < 16; ++r) wl[r] = wlr[r * 512];
        const float bias = P.in[10][h * 128 + d]; float run = 0.f;
#pragma unroll
        for (int ii = 0; ii < 16; ++ii) { const int i = 16 * qt + ii; float z = bias;
#pragma unroll
            for (int r4 = 0; r4 < 4; ++r4) { const f32x4 a = *(const LAS f32x4*)(alr + i * 16 + 4 * r4);
                z += a[0] * wl[4 * r4] + a[1] * wl[4 * r4 + 1] + a[2] * wl[4 * r4 + 2] + a[3] * wl[4 * r4 + 3]; }
            run += -softplusf_(-z) * (1.f / 16.f); bloc[ii] = run; }
        bqs[qt * 128 + d] = run;
    }
    __syncthreads();
    {
        float off = 0.f, tot = 0.f;
#pragma unroll
        for (int q = 0; q < 4; ++q) { const float t = bqs[q * 128 + d]; if (q < qt) off += t; tot += t; }
        const bf16* aq = (const bf16*)(ws + WS_AQ) + (size_t)t0 * 512 + h * 128 + d;
        const bf16* ak = (const bf16*)(ws + WS_AK) + (size_t)t0 * 512 + h * 128 + d;
#pragma unroll
        for (int ii = 0; ii < 16; ++ii) { const int i = 16 * qt + ii; const float bi = off + bloc[ii];
            const float qv = bf2f(aq[(size_t)i * 512]) * QSCALE * __expf(bi), kv = bf2f(ak[(size_t)i * 512]) * __expf(-bi);
            ((LAS bf16*)(lds + PL_Q))[i * LP + d] = (bf16)f2bf(qv); ((LAS bf16*)(lds + PL_K))[i * LP + d] = (bf16)f2bf(kv); }
        if (qt == 0) { bl[d] = tot; ((float*)(ws + WS_DEC))[((size_t)(b * NCHK + n) * 12 + 8 + h) * 128 + d] = __expf(tot); }
    }
    __syncthreads();
    att_frag<false>(lds, wave, lane, nullptr, (bf16*)(ws + WS_ATTA) + ((size_t)(b * NCHK + n) * 4 + h) * 4096);
    uchar* rQ = ws + WS_AQ + ((size_t)t0 * 512 + h * 128) * 2;
    uchar* rK = ws + WS_AK + ((size_t)t0 * 512 + h * 128) * 2;
#pragma unroll
    for (int e = 0; e < 2; ++e) {
        const int fl = tid + 512 * e, mt = fl >> 8, kt = (fl >> 6) & 3, r = fl & 15, kq = (fl >> 4) & 3, i = 16 * mt + r;
        const v2u a = *(const LAS v2u*)(lds + PL_Q + (i * LP + 32 * kt + 4 * kq) * 2), bq = *(const LAS v2u*)(lds + PL_Q + (i * LP + 32 * kt + 16 + 4 * kq) * 2);
        v4u o; o.x = a.x; o.y = a.y; o.z = bq.x; o.w = bq.y;
        *(v4u*)reg_addr(rQ, 1024, fl * 16) = o;
    }
#pragma unroll
    for (int e = 0; e < 2; ++e) {
        const int fl = tid + 512 * e, mt8 = fl >> 7, kt2 = (fl >> 6) & 1, r = fl & 15, kq = (fl >> 4) & 3, dd = 16 * mt8 + r;
        const float f = __expf(bl[dd]); float vv[8];
#pragma unroll
        for (int s = 0; s < 8; ++s) { const int j = 32 * kt2 + (s < 4 ? 4 * kq + s : 16 + 4 * kq + s - 4);
            vv[s] = bf2f(((const LAS bf16*)(lds + PL_K))[j * LP + dd]) * f; }
        v4u o; o.x = pk2(vv[0], vv[1]); o.y = pk2(vv[2], vv[3]); o.z = pk2(vv[4], vv[5]); o.w = pk2(vv[6], vv[7]);
        *(v4u*)reg_addr(rK, 1024, fl * 16) = o;
    }
#pragma unroll
    for (int e = 0; e < 8; ++e) {
        const int it = tid + 512 * e, g = it >> 11, sl = (it >> 8) & 7, mt = (it >> 6) & 3, ln = it & 63, c = ln & 15, rq = ln >> 4;
        const LAS bf16* vp = (const LAS bf16*)(lds + GL_V) + (16 * mt + 4 * rq) * VP + g * 128 + sl * 16 + c;
        v2u o; o.x = (unsigned)vp[0] | ((unsigned)vp[VP] << 16); o.y = (unsigned)vp[2 * VP] | ((unsigned)vp[3 * VP] << 16);
        uchar* rU = ws + WS_AV + ((size_t)t0 * 1024 + h * 256 + g * 128) * 2;
        *(v2u*)reg_addr(rU, 2048, ((sl * 4 + mt) * 64 + ln) * 8) = o;
    }
    __syncthreads();
}

constexpr int SC_W = 0, SC_Q = 16384, SC_K = 32768, SC_A = 49152, SC_U = 57344, SC_D = 65536, SC_BUF = 66048;
constexpr int SC_PF_DEPTH = 6;
struct ScStage { v4u w[2], q[2], k[2], u, a, d; };
__device__ __forceinline__ void phase_scan(const Params& P, LAS uchar* lds) {
    const int su = blockIdx.x & 63, pfk = ((int)blockIdx.x >> 6) - 1;
    const int tid = threadIdx.x, lane = tid & 63, s = tid >> 6, c = lane & 15, rq = lane >> 4;
    const bool gdn = su < 32;
    int b, h, g = 0, gh; if (gdn) { b = su >> 4; h = (su >> 1) & 7; gh = su & 1; } else { const int v = su - 32; b = v >> 4; h = (v >> 2) & 3; g = (v >> 1) & 1; gh = v & 1; }
    uchar* ws = P.ws;
    const uchar *pW, *pQ, *pK, *pA, *pD, *pU; uchar* pO; size_t sW, sQ, sA; int pitchQ, slot;
    if (gdn) {
        pW = ws + WS_WPK + ((size_t)(b * NCHK) * 8 + h) * 16384; sW = 8 * 16384;
        pQ = ws + WS_DQ + ((size_t)(b * SEQ) * 1024 + h * 128) * 2; pK = ws + WS_DK + ((size_t)(b * SEQ) * 1024 + h * 128) * 2; pitchQ = 2048; sQ = 64 * 2048;
        pU = ws + WS_DV + ((size_t)(b * SEQ) * 1024 + h * 128) * 2;
        pO = (uchar*)P.out + 64 * MiB + ((size_t)(b * SEQ) * 1024 + h * 128) * 2;
        pA = ws + WS_ATTD + ((size_t)(b * NCHK) * 8 + h) * 8192; sA = 8 * 8192; slot = h;
    } else {
        pW = nullptr; sW = 0;
        pQ = ws + WS_AQ + ((size_t)(b * SEQ) * 512 + h * 128) * 2; pK = ws + WS_AK + ((size_t)(b * SEQ) * 512 + h * 128) * 2; pitchQ = 1024; sQ = 64 * 1024;
        pU = ws + WS_AV + ((size_t)(b * SEQ) * 1024 + h * 256 + g * 128) * 2;
        pO = (uchar*)P.out + ((size_t)(b * SEQ) * 1024 + h * 256 + g * 128) * 2;
        pA = ws + WS_ATTA + ((size_t)(b * NCHK) * 4 + h) * 8192; sA = 4 * 8192; slot = 8 + h;
    }
    const size_t sU = 64 * 2048, sD = 12 * 512;
    pD = ws + WS_DEC + ((size_t)(b * NCHK) * 12 + slot) * 512;
    const unsigned ooff = (unsigned)(4 * rq * 1024 + gh * 64 + 16 * (s & 3) + c);
    unsigned* prog = (unsigned*)(ws + WS_PROG) + su * 64;
    if (pfk >= 0) {
        const int npf = ((int)gridDim.x >> 6) - 1;
        for (int n = pfk; n < NCHK; n += npf) {
            if (n > SC_PF_DEPTH) { int spins = 0;
                while ((int)__hip_atomic_load(prog, __ATOMIC_RELAXED, __HIP_MEMORY_SCOPE_AGENT) < n - SC_PF_DEPTH && ++spins < (1 << 18)) __builtin_amdgcn_s_sleep(8); }
            const uchar* a0; const int q = tid & 127;
            if (tid < 128) a0 = gdn ? pW + (size_t)n * sW + q * 128 : pA + (size_t)n * sA + (q & 63) * 128;
            else if (tid < 256) a0 = pQ + (size_t)n * sQ + (size_t)(q >> 1) * pitchQ + (q & 1) * 128;
            else if (tid < 384) a0 = pK + (size_t)n * sQ + (size_t)(q >> 1) * pitchQ + (q & 1) * 128;
            else a0 = pU + (size_t)n * sU + (size_t)(gh * 32 + ((q & 63) >> 1)) * 2048 + (q & 1) * 128;
            (void)*(const volatile unsigned*)a0;
            if (tid < 64) (void)*(const volatile unsigned*)(pA + (size_t)n * sA + tid * 128);
            else if (tid < 68) (void)*(const volatile unsigned*)(pD + (size_t)n * sD + (tid - 64) * 128);
        }
        return;
    }
    const v4u z4 = {0u, 0u, 0u, 0u};
#define SC_LOAD(R, n) do { \
        if (gdn) { R.w[0] = *(const v4u*)(pW + (size_t)(n) * sW + tid * 16); R.w[1] = *(const v4u*)(pW + (size_t)(n) * sW + (tid + 512) * 16); } \
        _Pragma("unroll") for (int e_ = 0; e_ < 2; ++e_) { const int i_ = tid + 512 * e_; \
            R.q[e_] = *(const v4u*)(pQ + (size_t)(n) * sQ + (size_t)(i_ >> 4) * pitchQ + (i_ & 15) * 16); \
            R.k[e_] = *(const v4u*)(pK + (size_t)(n) * sQ + (size_t)(i_ >> 4) * pitchQ + (i_ & 15) * 16); \
        } \
        R.u = *(const v4u*)(pU + (size_t)(n) * sU + (size_t)(gh * 32 + (tid >> 4)) * 2048 + (tid & 15) * 16); \
        R.a = *(const v4u*)(pA + (size_t)(n) * sA + tid * 16); \
        if (tid < 32) R.d = *(const v4u*)(pD + (size_t)(n) * sD + tid * 16); \
    } while (0)
#define SC_STORE(R, buf) do { LAS uchar* l_ = lds + (buf) * SC_BUF; \
        *(LAS v4u*)(l_ + SC_W + tid * 16) = R.w[0]; *(LAS v4u*)(l_ + SC_W + (tid + 512) * 16) = R.w[1]; \
        *(LAS v4u*)(l_ + SC_Q + tid * 16) = R.q[0]; *(LAS v4u*)(l_ + SC_Q + (tid + 512) * 16) = R.q[1]; \
        *(LAS v4u*)(l_ + SC_K + tid * 16) = R.k[0]; *(LAS v4u*)(l_ + SC_K + (tid + 512) * 16) = R.k[1]; \
        *(LAS v4u*)(l_ + SC_U + tid * 16) = R.u; \
        *(LAS v4u*)(l_ + SC_A + tid * 16) = R.a; \
        if (tid < 32) *(LAS v4u*)(l_ + SC_D + tid * 16) = R.d; \
    } while (0)
    f32x4 S[8];
#pragma unroll
    for (int i = 0; i < 8; ++i) S[i] = (f32x4){0.f, 0.f, 0.f, 0.f};
#define LDF(dst, off, i0) do { _Pragma("unroll") for (int i_ = 0; i_ < 8; ++i_) dst[i_] = *(const LAS bf16x8*)(L + (off) + (((i0) + i_) * 64 + lane) * 16); } while (0)
#define SC_STEP(n, buf) do { \
        const LAS uchar* L = lds + (buf) * SC_BUF; \
        bf16x8 fa[8], fb[8]; \
        v2u uu[4]; \
        _Pragma("unroll") for (int mt = 0; mt < 4; ++mt) uu[mt] = *(const LAS v2u*)(L + SC_U + (((s & 3) * 4 + mt) * 64 + lane) * 8); \
        if (gdn) { LDF(fa, SC_W, 0); LDF(fb, SC_W, 8); } else { LDF(fa, SC_Q, 0); LDF(fb, SC_Q, 8); } \
        bf16x8 Sb[4]; \
        _Pragma("unroll") for (int kt = 0; kt < 4; ++kt) Sb[kt] = pack8(S[2 * kt], S[2 * kt + 1]); \
        f32x4 vn[4]; \
        _Pragma("unroll") for (int mt = 0; mt < 4; ++mt) vn[mt] = (f32x4){bflo(uu[mt].x), bfhi(uu[mt].x), bflo(uu[mt].y), bfhi(uu[mt].y)}; \
        if (gdn) { \
            _Pragma("unroll") for (int mt = 0; mt < 2; ++mt) _Pragma("unroll") for (int kt = 0; kt < 4; ++kt) vn[mt] = MFMA16(fa[mt * 4 + kt], Sb[kt], vn[mt]); \
            LDF(fa, SC_Q, 0); \
            _Pragma("unroll") for (int mt = 0; mt < 2; ++mt) _Pragma("unroll") for (int kt = 0; kt < 4; ++kt) vn[2 + mt] = MFMA16(fb[mt * 4 + kt], Sb[kt], vn[2 + mt]); \
            LDF(fb, SC_Q, 8); \
        } \
        f32x4 o[4]; \
        _Pragma("unroll") for (int mt = 0; mt < 4; ++mt) o[mt] = (f32x4){0.f, 0.f, 0.f, 0.f}; \
        _Pragma("unroll") for (int mt = 0; mt < 2; ++mt) _Pragma("unroll") for (int kt = 0; kt < 4; ++kt) o[mt] = MFMA16(fa[mt * 4 + kt], Sb[kt], o[mt]); \
        LDF(fa, SC_A, 0); \
        _Pragma("unroll") for (int mt = 0; mt < 2; ++mt) _Pragma("unroll") for (int kt = 0; kt < 4; ++kt) o[2 + mt] = MFMA16(fb[mt * 4 + kt], Sb[kt], o[2 + mt]); \
        LDF(fb, SC_K, 0); \
        bf16x8 vb[2]; vb[0] = pack8(vn[0], vn[1]); vb[1] = pack8(vn[2], vn[3]); \
        f32x4 dvv[8]; \
        _Pragma("unroll") for (int m8 = 0; m8 < 8; ++m8) dvv[m8] = *(const LAS f32x4*)(L + SC_D + (16 * m8 + 4 * rq) * 4); \
        _Pragma("unroll") for (int mt = 0; mt < 4; ++mt) _Pragma("unroll") for (int k2 = 0; k2 < 2; ++k2) o[mt] = MFMA16(fa[mt * 2 + k2], vb[k2], o[mt]); \
        LDF(fa, SC_K, 8); \
        _Pragma("unroll") for (int m8 = 0; m8 < 4; ++m8) { f32x4 acc = S[m8] * dvv[m8]; \
            _Pragma("unroll") for (int k2 = 0; k2 < 2; ++k2) acc = MFMA16(fb[m8 * 2 + k2], vb[k2], acc); \
            S[m8] = acc; } \
        _Pragma("unroll") for (int m8 = 0; m8 < 4; ++m8) { f32x4 acc = S[4 + m8] * dvv[4 + m8]; \
            _Pragma("unroll") for (int k2 = 0; k2 < 2; ++k2) acc = MFMA16(fa[m8 * 2 + k2], vb[k2], acc); \
            S[4 + m8] = acc; } \
        { bf16* ob = (bf16*)(pO + (size_t)(n) * sU) + ooff; \
          _Pragma("unroll") for (int mt = 0; mt < 4; ++mt) { const unsigned p01 = pk2(o[mt][0], o[mt][1]), p23 = pk2(o[mt][2], o[mt][3]); \
                ob[(16 * mt + 0) * 1024] = (bf16)p01; ob[(16 * mt + 1) * 1024] = (bf16)(p01 >> 16); ob[(16 * mt + 2) * 1024] = (bf16)p23; ob[(16 * mt + 3) * 1024] = (bf16)(p23 >> 16); } } \
    } while (0)

    ScStage RA;
    RA.w[0] = z4; RA.w[1] = z4; RA.d = z4;
    SC_LOAD(RA, 0); SC_STORE(RA, 0);
    SC_LOAD(RA, 1);
    __syncthreads();
    for (int n = 0; n < NCHK; n += 2) {
        if (tid == 0) __hip_atomic_store(prog, (unsigned)n, __ATOMIC_RELAXED, __HIP_MEMORY_SCOPE_AGENT);
        SC_STORE(RA, 1);
        if (n + 2 < NCHK) SC_LOAD(RA, n + 2);
        if (s < 4) SC_STEP(n, 0);
        __syncthreads();
        if (n + 2 < NCHK) SC_STORE(RA, 0);
        if (n + 3 < NCHK) SC_LOAD(RA, n + 3);
        if (s < 4) SC_STEP(n + 1, 1);
        __syncthreads();
    }
#undef LDF
#undef SC_LOAD
#undef SC_STORE
#undef SC_STEP
}

#ifndef DBG_BRD_A
#define DBG_BRD_A 0
#endif
#ifndef DBG_BRD_B
#define DBG_BRD_B WS_WBD
#endif
#ifndef PREP_MASK
#define PREP_MASK 3
#endif
__device__ __forceinline__ void phase_prep(const Params& P, LAS uchar* lds) {
        if (PREP_MASK & 1) { int hcur = -1;
            for (int it = blockIdx.x; it < 4096; it += gridDim.x) {
                if ((it & 7) != hcur) { hcur = it & 7; __syncthreads();
                    for (int i = threadIdx.x; i < 1536; i += 512) { const int jr = i / 384, rr = i - jr * 384;
                        ((LAS float*)(lds + PL_CW))[i] = P.in[12][jr * 3072 + (rr >> 7) * 1024 + hcur * 128 + (rr & 127)]; }
                    __syncthreads(); }
                prep_gdn(P, lds, it); } }
        if (PREP_MASK & 2) for (int it = blockIdx.x; it < 2048; it += gridDim.x) prep_gla(P, lds, it);
}
__global__ void __launch_bounds__(512, 2) mega_fwd(Params P) {
    extern __shared__ __attribute__((aligned(16))) unsigned char shm[];
    LAS uchar* lds = (LAS uchar*)shm;
    cg::grid_group grid = cg::this_grid();
    uchar* ws = P.ws;
    const int lo = P.lo, hi = P.hi;
#ifndef PH_MASK
#define PH_MASK 0x3fff
#endif
#define IN(k) (((PH_MASK >> (k)) & 1) && lo <= (k) && (k) < hi)
#ifndef REP_MASK
#define REP_MASK 0
#endif
#define REP(k) ((REP_MASK >> (k)) & 1)
#define SEAM(k) do { if (IN(k) && IN((k) + 1)) grid.sync(); } while (0)
    if (IN(0)) { phase0(P, lds); if (REP(0)) { grid.sync(); phase0(P, lds); } } SEAM(0);
    if (IN(1)) { phase_norm1<false>(P); if (REP(1)) { grid.sync(); phase_norm1<false>(P); } } SEAM(1);
    if (IN(2)) { run_gemm<M_INPROJ>(lds, (const bf16*)(ws + WS_HB), (const bf16*)(ws + WS_WIN), WIN1_ROWS, 1024, ws, nullptr, nullptr); if (REP(2)) { grid.sync(); run_gemm<M_INPROJ>(lds, (const bf16*)(ws + WS_HB), (const bf16*)(ws + WS_WIN), WIN1_ROWS, 1024, ws, nullptr, nullptr); } } SEAM(2);
    if (IN(3)) { phase_prep(P, lds); if (REP(3)) { grid.sync(); run_gemm<M_INPROJ>(lds, (const bf16*)(ws + WS_HB), (const bf16*)(ws + WS_WIN), WIN1_ROWS, 1024, ws, nullptr, nullptr); grid.sync(); phase_prep(P, lds); }
    } SEAM(3);
    if (IN(4)) { phase_scan(P, lds); if (REP(4)) { grid.sync(); phase_scan(P, lds); } } SEAM(4);
    if (IN(5)) { phase_norm1<true>(P); if (REP(5)) { grid.sync(); phase_norm1<true>(P); } } SEAM(5);
    if (IN(6)) { run_gemm<M_GATES>(lds, (const bf16*)(ws + WS_HB), (const bf16*)(ws + WS_WIN) + (size_t)WIN1_ROWS * 1024, WIN2_ROWS, 1024, ws, P.in[11], P.in[15], (uchar*)P.out); if (REP(6)) { grid.sync(); run_gemm<M_GATES>(lds, (const bf16*)(ws + WS_HB), (const bf16*)(ws + WS_WIN) + (size_t)WIN1_ROWS * 1024, WIN2_ROWS, 1024, ws, P.in[11], P.in[15], (uchar*)P.out); } } SEAM(6);
    if (IN(7)) { run_gemm<M_BRA>(lds, (const bf16*)P.out, (const bf16*)(ws + WS_WBG), 1024, 1024, ws, nullptr, nullptr); if (REP(7)) { grid.sync(); run_gemm<M_BRA>(lds, (const bf16*)P.out, (const bf16*)(ws + WS_WBG), 1024, 1024, ws, nullptr, nullptr); } } SEAM(7);
    if (IN(8)) { run_gemm<M_BRD>(lds, (const bf16*)((const uchar*)P.out + 64 * MiB), (const bf16*)(ws + DBG_BRD_B), 1024, 1024, ws, nullptr, nullptr); if (REP(8)) { grid.sync(); run_gemm<M_BRD>(lds, (const bf16*)((const uchar*)P.out + 64 * MiB), (const bf16*)(ws + DBG_BRD_B), 1024, 1024, ws, nullptr, nullptr); } } SEAM(8);
    if (IN(9)) { run_gemm<M_OUT>(lds, (const bf16*)(ws + WS_MG), (const bf16*)(ws + WS_WOUT), 1024, 1024, ws, nullptr, nullptr); if (REP(9)) { grid.sync(); run_gemm<M_OUT>(lds, (const bf16*)(ws + WS_MG), (const bf16*)(ws + WS_WOUT), 1024, 1024, ws, nullptr, nullptr); } } SEAM(9);
    if (IN(10)) { phase_row1(P); if (REP(10)) { grid.sync(); phase_row1(P); } } SEAM(10);
    if (IN(11)) { run_gemm<M_MLP1>(lds, (const bf16*)(ws + WS_H2), (const bf16*)(ws + WS_W1), 4096, 1024, ws, nullptr, nullptr); if (REP(11)) { grid.sync(); run_gemm<M_MLP1>(lds, (const bf16*)(ws + WS_H2), (const bf16*)(ws + WS_W1), 4096, 1024, ws, nullptr, nullptr); } } SEAM(11);
    if (IN(12)) { run_gemm<M_MLP2>(lds, (const bf16*)(ws + WS_A1), (const bf16*)(ws + WS_W2), 1024, 4096, ws, nullptr, nullptr); if (REP(12)) { grid.sync(); run_gemm<M_MLP2>(lds, (const bf16*)(ws + WS_A1), (const bf16*)(ws + WS_W2), 1024, 4096, ws, nullptr, nullptr); } } SEAM(12);
    if (IN(13)) { phase_row2(P); }
#undef IN
#undef SEAM
}

#ifdef DBG_STOP
__global__ void __launch_bounds__(256) dbg_dump(const bf16* src, float* out) {
    for (size_t i = (size_t)blockIdx.x * 256 + threadIdx.x; i < (size_t)T * 1024; i += (size_t)gridDim.x * 256) { unsigned hsh = ((unsigned)src[i] + 1u) * 2654435761u; hsh ^= hsh >> 15; hsh *= 2246822519u; out[i] = (float)(hsh >> 8) * (1.0f / 16777216.0f); }
}
#endif
#ifndef N_LAUNCH_MODE
#define N_LAUNCH_MODE 1
#endif
extern "C" void kernel_launch(void* const* d_in, const int* in_sizes, int n_in, void* d_out, int out_size, void* d_ws, size_t ws_size, hipStream_t stream) {
    static int grid_blocks = 0;
    if (!grid_blocks) {
        int dev = 0, cus = 0, per_cu = 0;
        hipGetDevice(&dev);
        hipDeviceGetAttribute(&cus, hipDeviceAttributeMultiprocessorCount, dev);
        hipFuncSetAttribute((const void*)mega_fwd, hipFuncAttributeMaxDynamicSharedMemorySize, LDS_BYTES);
        hipOccupancyMaxActiveBlocksPerMultiprocessor(&per_cu, (const void*)mega_fwd, 512, LDS_BYTES);
        if (per_cu < 1) { fprintf(stderr, "kernel_launch: occupancy query gives %d blocks per CU\n", per_cu); per_cu = 1; }
        grid_blocks = cus * per_cu;
        if (grid_blocks > 256) grid_blocks = 256;
        if (n_in != 21 || ws_size < WS_END) fprintf(stderr, "kernel_launch: unexpected n_in %d or ws_size %zu (< %zu)\n", n_in, ws_size, (size_t)WS_END);
    }
    Params p{};
    for (int i = 0; i < 21; ++i) p.in[i] = (const float*)d_in[i];
    p.out = (float*)d_out; p.ws = (uchar*)d_ws;
    if (N_LAUNCH_MODE == 1) {
        p.lo = 0; p.hi = NPHASE;
        void* args[] = {&p};
        hipError_t e = hipLaunchCooperativeKernel((const void*)mega_fwd, dim3(grid_blocks), dim3(512), args, LDS_BYTES, stream);
        if (e != hipSuccess) fprintf(stderr, "cooperative launch failed: %s (grid %d)\n", hipGetErrorString(e), grid_blocks);
    } else {
#ifdef DBG_STOP
        for (int k = 0; k <= DBG_STOP; ++k) { p.lo = k; p.hi = k + 1; hipLaunchKernelGGL(mega_fwd, dim3(grid_blocks), dim3(512), LDS_BYTES, stream, p); }
        hipLaunchKernelGGL(dbg_dump, dim3(2048), dim3(256), 0, stream, (const bf16*)((uchar*)d_ws + (size_t)DBG_SRC * MiB), (float*)d_out);
#else
        for (int k = 0; k < NPHASE; ++k) { p.lo = k; p.hi = k + 1; hipLaunchKernelGGL(mega_fwd, dim3(grid_blocks), dim3(512), LDS_BYTES, stream, p); }
#endif
    }
}
```

```cpp
#include <hip/hip_runtime.h>
#include <hip/hip_cooperative_groups.h>
#include <cstdio>
#include <cstdint>
namespace cg = cooperative_groups;
namespace pg8 {
#define PG8_LAS __attribute__((address_space(3)))
typedef unsigned short bf16_t;
typedef short bf16x8 __attribute__((ext_vector_type(8)));
typedef float f32x4 __attribute__((ext_vector_type(4)));
typedef unsigned u32x4 __attribute__((ext_vector_type(4)));
constexpr int BM = 256, BK = 64, HALF = 128, HTB = HALF * BK * 2  , STAGE_BYTES = 8 * HTB, NXCD = 8, WGM = 4;

__host__ __device__ __forceinline__ int lds_byte(int r, int c) { const int st = (r >> 4) * 2 + (c >> 5), rr = r & 15, cc = c & 31, ob = rr * 64 + cc * 2; return st * 1024 + (ob ^ (((ob >> 9) & 1) << 5)); }
__host__ __device__ __forceinline__ void stage_rc(int b, int& R, int& C) { const int st = b / 1024, sb = b % 1024, swz = sb ^ (((sb >> 9) & 1) << 5); R = (st >> 1) * 16 + swz / 64; C = (st & 1) * 32 + (swz % 64) / 2; }
__host__ __device__ __forceinline__ int perm32(int rho) { const int n = rho >> 4, i = rho & 15; return 8 * (i >> 2) + 4 * n + (i & 3); }

struct Unit { int pm, pn; };
struct Gemm { const bf16_t* A; const bf16_t* Bt; int M, N, K; };

struct StaticOrder {
    int nM, nN, nwg, G, c;
    __host__ __device__ void init(int M, int N, int G_, int c_) { nM = M / BM; nN = N / BM; nwg = nM * nN; G = G_; c = c_; }
    __host__ __device__ bool next(int i, Unit& u) const {
        const long L = (long)i * G + c; if (L >= nwg) return false;
        int wgid = (int)L; { const int q = nwg / NXCD, r = nwg % NXCD, xcd = wgid % NXCD, off = wgid / NXCD; wgid = (xcd < r ? xcd * (q + 1) : r * (q + 1) + (xcd - r) * q) + off; }
        const int nig = WGM * nN, gid = wgid / nig, fm = gid * WGM, gsz = (nM - fm) < WGM ? (nM - fm) : WGM;
        u.pm = fm + ((wgid % nig) % gsz); u.pn = (wgid % nig) / gsz; return true;
    }
    __device__ __forceinline__ void a_ready(const Unit&) const {}
    __device__ __forceinline__ void done(const Unit&) const {}
};
__device__ __forceinline__ unsigned cvt_pk_bf16(float lo, float hi) { unsigned r; asm volatile("v_cvt_pk_bf16_f32 %0, %1, %2" : "=v"(r) : "v"(lo), "v"(hi)); return r; }
template <class Epi, class Sched, bool ALIGN_EPI = false, bool SP2 = false>
__device__ __forceinline__ void gemm_phase(PG8_LAS unsigned char* lds, const Gemm g, const Sched& S, const Epi& E) {
    const int tid = threadIdx.x, wid = __builtin_amdgcn_readfirstlane(tid >> 6), lane = tid & 63, wr = wid >> 2, wc = wid & 3, fr = lane & 15, fq = lane >> 4;
    const int K = g.K, nt = K / BK;
    unsigned voffA[2], voffB[2];
#pragma unroll
    for (int i = 0; i < 2; ++i) { int R, C; stage_rc(tid * 16 + i * 8192, R, C); const int Rb = Epi::PERM ? ((R & ~31) + perm32(R & 31)) : R;
        voffA[i] = (unsigned)(R * K + C) * 2u; voffB[i] = (unsigned)(Rb * K + C) * 2u; }
    const size_t kstep = (size_t)(BK * 2);
    const size_t hstep = (size_t)HALF * K * 2;
    const size_t tstep = 2 * hstep;
    const unsigned ldsw = (unsigned)wid * 1024u;
    const int aoff = lds_byte(wr * 64 + fr, fq * 8), boff = lds_byte(wc * 32 + fr, fq * 8);
#define PG8_SA(b, h) (((b) * 2 + (h)) * HTB)
#define PG8_SB(b, h) ((4 + (b) * 2 + (h)) * HTB)
#define PG8_STAGE(bufoff, gbase, voff) do { _Pragma("unroll") for (int _i = 0; _i < 2; ++_i) \
        __builtin_amdgcn_global_load_lds((const unsigned*)((const char*)(gbase) + (voff)[_i]), (PG8_LAS unsigned*)(lds + (bufoff) + ldsw + _i * 8192), 16, 0, 0); } while (0)
#define PG8_LDA(dst, b, h) do { _Pragma("unroll") for (int m = 0; m < 4; ++m) _Pragma("unroll") for (int k = 0; k < 2; ++k) dst[m][k] = *(const PG8_LAS bf16x8*)(lds + PG8_SA(b, h) + aoff + m * 2048 + k * 1024); } while (0)
#define PG8_LDB(dst, b, h) do { _Pragma("unroll") for (int n = 0; n < 2; ++n) _Pragma("unroll") for (int k = 0; k < 2; ++k) dst[n][k] = *(const PG8_LAS bf16x8*)(lds + PG8_SB(b, h) + boff + n * 2048 + k * 1024); } while (0)
#define PG8_MMA(ai, bj, At, Bt) do { __builtin_amdgcn_s_setprio(1); _Pragma("unroll") for (int m = 0; m < 4; ++m) _Pragma("unroll") for (int n = 0; n < 2; ++n) _Pragma("unroll") for (int k = 0; k < 2; ++k) \
        acc[ai][bj][m][n] = __builtin_amdgcn_mfma_f32_16x16x32_bf16(Bt[n][k], At[m][k], acc[ai][bj][m][n], 0, 0, 0); __builtin_amdgcn_s_setprio(0); } while (0)
#define PG8_WAIT_V(n) asm volatile("s_waitcnt vmcnt(" #n ")" ::: "memory")
#define PG8_WAIT_L(n) asm volatile("s_waitcnt lgkmcnt(" #n ")" ::: "memory")
#define PG8_BAR __builtin_amdgcn_s_barrier()
#define PG8_SCHED __builtin_amdgcn_sched_barrier(0)
    Unit cur, nxt; int ui = 0;
    if (!S.next(0, cur)) return;
    f32x4 acc[2][2][4][2];
#pragma unroll
    for (int a = 0; a < 2; ++a)
#pragma unroll
        for (int b = 0; b < 2; ++b)
#pragma unroll
            for (int m = 0; m < 4; ++m)
#pragma unroll
                for (int n = 0; n < 2; ++n) acc[a][b][m][n] = (f32x4){0.f, 0.f, 0.f, 0.f};
    bf16x8 At[4][2], B0[2][2], B1[2][2];
    const char* cA = (const char*)g.A + (size_t)cur.pm * tstep; const char* cB = (const char*)g.Bt + (size_t)cur.pn * tstep;
    S.a_ready(cur);
    if constexpr (SP2) {
        PG8_STAGE(PG8_SB(0, 0), cB, voffB); PG8_STAGE(PG8_SB(0, 1), cB + hstep, voffB); PG8_STAGE(PG8_SA(0, 0), cA, voffA); PG8_STAGE(PG8_SA(0, 1), cA + hstep, voffA);
        if (wr == 1) PG8_BAR;
        PG8_WAIT_V(2); PG8_BAR;
        PG8_STAGE(PG8_SB(1, 0), cB + kstep, voffB); PG8_STAGE(PG8_SA(1, 0), cA + kstep, voffA); PG8_STAGE(PG8_SB(1, 1), cB + hstep + kstep, voffB);
        PG8_WAIT_V(6); PG8_BAR;
    } else {
        PG8_STAGE(PG8_SB(0, 0), cB, voffB); PG8_STAGE(PG8_SA(0, 0), cA, voffA); PG8_STAGE(PG8_SB(0, 1), cB + hstep, voffB); PG8_STAGE(PG8_SA(0, 1), cA + hstep, voffA);
        if (wr == 1) PG8_BAR;
        PG8_WAIT_V(4); PG8_BAR;
        PG8_STAGE(PG8_SB(1, 0), cB + kstep, voffB); PG8_STAGE(PG8_SA(1, 0), cA + kstep, voffA); PG8_STAGE(PG8_SB(1, 1), cB + hstep + kstep, voffB);
        PG8_WAIT_V(6); PG8_BAR;
    }
    for (;;) {
        const bool has_next = S.next(ui + 1, nxt);
        const char* nA = has_next ? (const char*)g.A + (size_t)nxt.pm * tstep : cA; const char* nB = has_next ? (const char*)g.Bt + (size_t)nxt.pn * tstep : cB;
        for (int t = 0; t < nt; t += 2) {
            const bool last = (t == nt - 2);
            const char* a1 = cA + (size_t)(t + 1) * kstep;
            const char* a2 = last ? nA : cA + (size_t)(t + 2) * kstep; const char* b2 = last ? nB : cB + (size_t)(t + 2) * kstep;
            const char* a3 = a2 + kstep; const char* b3 = b2 + kstep;
            if (last && has_next) S.a_ready(nxt);
            if constexpr (SP2) {
            PG8_LDB(B0, 0, 0); PG8_LDB(B1, 0, 1); PG8_SCHED; PG8_LDA(At, 0, 0); PG8_STAGE(PG8_SA(1, 1), a1 + hstep, voffA);
            PG8_WAIT_V(8); PG8_WAIT_L(0); PG8_BAR; PG8_MMA(0, 0, At, B0); PG8_MMA(0, 1, At, B1); PG8_BAR; PG8_SCHED;
            PG8_LDA(At, 0, 1); PG8_STAGE(PG8_SB(0, 0), b2, voffB); PG8_STAGE(PG8_SB(0, 1), b2 + hstep, voffB); PG8_STAGE(PG8_SA(0, 0), a2, voffA);
            PG8_WAIT_V(8); PG8_WAIT_L(0); PG8_BAR; PG8_MMA(1, 0, At, B0); PG8_MMA(1, 1, At, B1); PG8_BAR; PG8_SCHED;
            PG8_LDB(B0, 1, 0); PG8_LDB(B1, 1, 1); PG8_SCHED; PG8_LDA(At, 1, 0); PG8_STAGE(PG8_SA(0, 1), a2 + hstep, voffA);
            PG8_WAIT_V(8); PG8_WAIT_L(0); PG8_BAR; PG8_MMA(0, 0, At, B0); PG8_MMA(0, 1, At, B1); PG8_BAR; PG8_SCHED;
            PG8_LDA(At, 1, 1); PG8_STAGE(PG8_SB(1, 0), b3, voffB); PG8_STAGE(PG8_SB(1, 1), b3 + hstep, voffB); PG8_STAGE(PG8_SA(1, 0), a3, voffA);
            PG8_WAIT_V(8); PG8_WAIT_L(0); PG8_BAR; PG8_MMA(1, 0, At, B0); PG8_MMA(1, 1, At, B1); PG8_BAR; PG8_SCHED;
            } else {
            PG8_LDB(B0, 0, 0); PG8_SCHED; PG8_LDA(At, 0, 0); PG8_STAGE(PG8_SA(1, 1), a1 + hstep, voffA);
            PG8_WAIT_L(8); PG8_BAR; PG8_WAIT_L(0); PG8_MMA(0, 0, At, B0); PG8_BAR; PG8_SCHED;
            PG8_LDB(B1, 0, 1); PG8_STAGE(PG8_SB(0, 0), b2, voffB);
            PG8_BAR; PG8_WAIT_L(0); PG8_MMA(0, 1, At, B1); PG8_BAR;
            PG8_LDA(At, 0, 1); PG8_STAGE(PG8_SA(0, 0), a2, voffA);
            PG8_BAR; PG8_WAIT_L(0); PG8_MMA(1, 0, At, B0); PG8_BAR; PG8_SCHED;
            PG8_STAGE(PG8_SB(0, 1), b2 + hstep, voffB);
            PG8_WAIT_V(6); PG8_BAR; PG8_MMA(1, 1, At, B1); PG8_BAR;
            PG8_LDB(B0, 1, 0); PG8_SCHED; PG8_LDA(At, 1, 0); PG8_STAGE(PG8_SA(0, 1), a2 + hstep, voffA);
            PG8_WAIT_L(8); PG8_BAR; PG8_WAIT_L(0); PG8_MMA(0, 0, At, B0); PG8_BAR; PG8_SCHED;
            PG8_LDB(B1, 1, 1); PG8_STAGE(PG8_SB(1, 0), b3, voffB);
            PG8_BAR; PG8_WAIT_L(0); PG8_MMA(0, 1, At, B1); PG8_BAR;
            PG8_LDA(At, 1, 1); PG8_STAGE(PG8_SA(1, 0), a3, voffA);
            PG8_BAR; PG8_WAIT_L(0); PG8_MMA(1, 0, At, B0); PG8_BAR; PG8_SCHED;
            PG8_STAGE(PG8_SB(1, 1), b3 + hstep, voffB);
            PG8_WAIT_V(6); PG8_BAR; PG8_MMA(1, 1, At, B1); PG8_BAR;
            }
        }
        if constexpr (ALIGN_EPI) { if (wr == 0) PG8_BAR; }
        if constexpr (!Epi::AFTER_DRAIN) { E(acc, cur, wr, wc, fr, fq); S.done(cur); }
        if (!has_next) break;
#pragma unroll
        for (int a = 0; a < 2; ++a)
#pragma unroll
            for (int b = 0; b < 2; ++b)
#pragma unroll
                for (int m = 0; m < 4; ++m)
#pragma unroll
                    for (int n = 0; n < 2; ++n) acc[a][b][m][n] = (f32x4){0.f, 0.f, 0.f, 0.f};
        cur = nxt; cA = nA; cB = nB; ++ui;
        if constexpr (ALIGN_EPI) { if (wr == 1) PG8_BAR; }
    }
    PG8_WAIT_V(0);
    if constexpr (!ALIGN_EPI) { if (wr == 0) PG8_BAR; }
    PG8_BAR;
    if constexpr (Epi::AFTER_DRAIN) { E.fused(acc, cur, wr, wc, fr, fq, lds, wid, lane); S.done(cur); }
#undef PG8_SA
#undef PG8_SB
#undef PG8_STAGE
#undef PG8_LDA
#undef PG8_LDB
#undef PG8_MMA
#undef PG8_WAIT_V
#undef PG8_WAIT_L
#undef PG8_BAR
#undef PG8_SCHED
}
}

#define LAS __attribute__((address_space(3)))
typedef unsigned short bf16;
typedef unsigned char uchar;
typedef unsigned v4u __attribute__((ext_vector_type(4)));
typedef unsigned v2u __attribute__((ext_vector_type(2)));
typedef float f32x4 __attribute__((ext_vector_type(4)));
typedef short bf16x8 __attribute__((ext_vector_type(8)));
#define MFMA16(a, b, c) __builtin_amdgcn_mfma_f32_16x16x32_bf16((a), (b), (c), 0, 0, 0)

constexpr int T = 32768, DM = 1024, SEQ = 16384, NCHK = 256;
constexpr float EPS = 1e-6f;
constexpr size_t MiB = 1u << 20;
constexpr size_t WS_PROG = 65536;
constexpr size_t WS_MOD = 0, WS_SS = 1 * MiB, WS_DEC = 3 * MiB, WS_SM = 6 * MiB, WS_HALO = 10 * MiB;
constexpr size_t WS_WIN = 20 * MiB, WS_WBG = 39 * MiB, WS_WBD = 41 * MiB, WS_WOUT = 43 * MiB, WS_W1 = 45 * MiB, WS_W2 = 53 * MiB;
constexpr size_t WS_HB = 64 * MiB, WS_AQ = 128 * MiB, WS_AK = 160 * MiB, WS_AV = 192 * MiB, WS_DQ = 256 * MiB, WS_DK = 320 * MiB, WS_DV = 384 * MiB;
constexpr size_t WS_ATTD = 448 * MiB, WS_ATTA = 480 * MiB, WS_SSP = 496 * MiB, WS_END = 512 * MiB;
constexpr size_t WS_SGA = 128 * MiB, WS_SGD = 256 * MiB, WS_YA = 320 * MiB, WS_MG = 128 * MiB, WS_Z = 256 * MiB, WS_H2 = 64 * MiB, WS_A1 = 128 * MiB, WS_Y = 384 * MiB;
constexpr int WIN1_ROWS = 5376, WIN2_ROWS = 4096;
constexpr int LDS_BYTES = 163840;
constexpr int NPHASE = 14;

struct Params { const float* in[21]; float* out; uchar* ws; int lo, hi; };

typedef float f32x2_ __attribute__((ext_vector_type(2)));
typedef __bf16 bf16x2_ __attribute__((ext_vector_type(2)));
__device__ __forceinline__ unsigned f2bf(float f) { unsigned u = __float_as_uint(f); return (u + 0x7fffu + ((u >> 16) & 1u)) >> 16; }
__device__ __forceinline__ unsigned pk2(float lo, float hi) { const f32x2_ v = {lo, hi}; return __builtin_bit_cast(unsigned, __builtin_convertvector(v, bf16x2_)); }
__device__ __forceinline__ float bf2f(unsigned b) { return __uint_as_float(b << 16); }
__device__ __forceinline__ float bflo(unsigned w) { return __uint_as_float(w << 16); }
__device__ __forceinline__ float bfhi(unsigned w) { return __uint_as_float(w & 0xffff0000u); }
__device__ __forceinline__ bf16x8 pack8(f32x4 a, f32x4 b) { v4u p; p.x = pk2(a[0], a[1]); p.y = pk2(a[2], a[3]); p.z = pk2(b[0], b[1]); p.w = pk2(b[2], b[3]); return __builtin_bit_cast(bf16x8, p); }
typedef unsigned u32x2_ __attribute__((ext_vector_type(2)));
template <int CTRL> __device__ __forceinline__ float dpp_mov(float v) { return __uint_as_float(__builtin_amdgcn_update_dpp(0u, __float_as_uint(v), CTRL, 0xf, 0xf, true)); }
__device__ __forceinline__ float row16_sum(float v) { v += dpp_mov<0xB1>(v); v += dpp_mov<0x4E>(v); v += dpp_mov<0x141>(v); v += dpp_mov<0x140>(v); return v; }
__device__ __forceinline__ float xsum16(float x) { const unsigned u = __float_as_uint(x); const u32x2_ r = __builtin_amdgcn_permlane16_swap(u, u, false, false); return __uint_as_float(r.x) + __uint_as_float(r.y); }
__device__ __forceinline__ float xsum32(float x) { const unsigned u = __float_as_uint(x); const u32x2_ r = __builtin_amdgcn_permlane32_swap(u, u, false, false); return __uint_as_float(r.x) + __uint_as_float(r.y); }
__device__ __forceinline__ float wave_sum(float v) { return xsum32(xsum16(row16_sum(v))); }
__device__ __forceinline__ float sigmoidf_(float x) { return __builtin_amdgcn_rcpf(1.0f + __expf(-x)); }
__device__ __forceinline__ float siluf_(float x) { return x * __builtin_amdgcn_rcpf(1.0f + __expf(-x)); }
__device__ __forceinline__ float softplusf_(float x) { return fmaxf(x, 0.f) + __logf(1.0f + __expf(-fabsf(x))); }

__device__ __forceinline__ int win_dest_row(int j) {
    if (j < 2048) return j;
    if (j < 3072) return WIN1_ROWS + (j - 2048);
    if (j < 3088) return 5120 + (j - 3072);
    if (j < 6160) return 2048 + (j - 3088);
    if (j < 7184) return WIN1_ROWS + 1024 + (j - 6160);
    if (j < 7200) return 5136 + (j - 7184);
    return WIN1_ROWS + 2048 + (j - 7200);
}
template <bool REMAP>
__device__ __forceinline__ void tr_item(const float* W, int K, int N, bf16* WT, LAS float* scr, int item, int lane) {
    const int nblk = N / 32, kb = item / nblk, nb = item % nblk, k0 = 64 * kb, n0 = 32 * nb;
#pragma unroll 16
    for (int i = 0; i < 32; ++i) { const int kk = 2 * i + (lane >> 5); scr[kk * 33 + (lane & 31)] = W[(size_t)(k0 + kk) * N + n0 + (lane & 31)]; }
    asm volatile("s_waitcnt lgkmcnt(0)" ::: "memory");
    const int c = lane & 7;
#pragma unroll
    for (int j = 0; j < 4; ++j) { const int n = (lane >> 3) + 8 * j; const LAS float* s = scr + (8 * c) * 33 + n;
        v4u o; o.x = pk2(s[0 * 33], s[1 * 33]); o.y = pk2(s[2 * 33], s[3 * 33]); o.z = pk2(s[4 * 33], s[5 * 33]); o.w = pk2(s[6 * 33], s[7 * 33]);
        const int dr = REMAP ? win_dest_row(n0 + n) : (n0 + n);
        *(v4u*)(WT + (size_t)dr * K + k0 + 8 * c) = o; }
    asm volatile("s_waitcnt lgkmcnt(0)" ::: "memory");
}
template <bool DO_W, bool DO_MOD>
__device__ __forceinline__ void phase0(const Params& P, LAS uchar* lds) {
    const int tid = threadIdx.x, lane = tid & 63, wave = tid >> 6;
    const int gw = blockIdx.x * 8 + wave, NGW = gridDim.x * 8;
    LAS float* scr = (LAS float*)(lds + wave * 16384);
    uchar* ws = P.ws;
    constexpr int I_IN = 16 * 289, I_SQ = 16 * 32, I_1 = 16 * 128, I_2 = 64 * 32;
    constexpr int NITEMS = I_IN + 3 * I_SQ + I_1 + I_2;
    if constexpr (DO_W)
    for (int it = gw; it < NITEMS; it += NGW) {
        int r = it;
        if (r < I_IN) { tr_item<true>(P.in[8], 1024, 9248, (bf16*)(ws + WS_WIN), scr, r, lane); continue; } r -= I_IN;
        if (r < I_SQ) { tr_item<false>(P.in[16], 1024, 1024, (bf16*)(ws + WS_WBG), scr, r, lane); continue; } r -= I_SQ;
        if (r < I_SQ) { tr_item<false>(P.in[17], 1024, 1024, (bf16*)(ws + WS_WBD), scr, r, lane); continue; } r -= I_SQ;
        if (r < I_SQ) { tr_item<false>(P.in[18], 1024, 1024, (bf16*)(ws + WS_WOUT), scr, r, lane); continue; } r -= I_SQ;
        if (r < I_1) { tr_item<false>(P.in[19], 1024, 4096, (bf16*)(ws + WS_W1), scr, r, lane); continue; } r -= I_1;
        tr_item<false>(P.in[20], 4096, 1024, (bf16*)(ws + WS_W2), scr, r, lane);
    }
    if (blockIdx.x == 0 && tid < 64) ((unsigned*)(ws + WS_PROG))[tid * 64] = 0u;
    { v4u* z = (v4u*)(ws + WS_WIN + (size_t)5152 * 2048); const int n16 = 224 * 128; const v4u zz = {0u, 0u, 0u, 0u};
      for (int i = blockIdx.x * 512 + tid; i < n16; i += gridDim.x * 512) z[i] = zz; }
    float* mod = (float*)(ws + WS_MOD);
    const float* cvec = P.in[1]; const float* aw = P.in[2]; const float* ab = P.in[3];
    if constexpr (DO_MOD)
    for (int task = gw; task < 384; task += NGW) {
        const int cq = lane & 3, rg = lane >> 2, col = task * 16 + cq * 4;
        f32x4 a0 = {0.f, 0.f, 0.f, 0.f}, a1 = {0.f, 0.f, 0.f, 0.f};
#pragma unroll 8
        for (int i = 0; i < 64; ++i) { const int k = rg + 16 * i;
            const float s0 = siluf_(cvec[k]), s1 = siluf_(cvec[1024 + k]);
            const f32x4 w = *(const f32x4*)(aw + (size_t)k * 6144 + col);
            a0 += w * s0; a1 += w * s1; }
#pragma unroll
        for (int e = 0; e < 4; ++e) {
#pragma unroll
            for (int o = 4; o < 64; o <<= 1) { a0[e] += __shfl_xor(a0[e], o); a1[e] += __shfl_xor(a1[e], o); } }
        if (rg == 0) { const f32x4 bb = *(const f32x4*)(ab + col); *(f32x4*)(mod + col) = a0 + bb; *(f32x4*)(mod + 6144 + col) = a1 + bb; }
    }
}

template <bool WITH_SS>
__device__ __forceinline__ void phase_norm1(const Params& P) {
    const int tid = threadIdx.x, lane = tid & 63, wave = tid >> 6;
    const int gw = blockIdx.x * 8 + wave, NGW = gridDim.x * 8;
    const float* x = P.in[0]; const float* w = P.in[4]; const float* mod = (const float*)(P.ws + WS_MOD);
    bf16* hb = (bf16*)(P.ws + WS_HB);
    f32x4 vnx[4]; v2u qan[4], qdn[4];
    if (gw < T) {
#pragma unroll
        for (int j = 0; j < 4; ++j) { vnx[j] = ((const f32x4*)(x + (size_t)gw * DM) + lane)[64 * j];
            if constexpr (WITH_SS) { qan[j] = ((const v2u*)((const bf16*)P.out + (size_t)gw * DM) + lane)[64 * j]; qdn[j] = ((const v2u*)((const bf16*)((const uchar*)P.out + 64 * MiB) + (size_t)gw * DM) + lane)[64 * j]; } }
    }
    for (int m = gw; m < T; m += NGW) {
        const int b = m / SEQ; const float* mb = mod + b * 6144;
        f32x4 v[4]; v2u qac[4], qdc[4]; float s = 0.f;
#pragma unroll
        for (int j = 0; j < 4; ++j) { v[j] = vnx[j]; if constexpr (WITH_SS) { qac[j] = qan[j]; qdc[j] = qdn[j]; } }
        if (m + NGW < T) {
            const int mn = m + NGW;
#pragma unroll
            for (int j = 0; j < 4; ++j) { vnx[j] = ((const f32x4*)(x + (size_t)mn * DM) + lane)[64 * j];
                if constexpr (WITH_SS) { qan[j] = ((const v2u*)((const bf16*)P.out + (size_t)mn * DM) + lane)[64 * j]; qdn[j] = ((const v2u*)((const bf16*)((const uchar*)P.out + 64 * MiB) + (size_t)mn * DM) + lane)[64 * j]; } }
        }
#pragma unroll
        for (int j = 0; j < 4; ++j) s += (v[j][0] * v[j][0] + v[j][1] * v[j][1]) + (v[j][2] * v[j][2] + v[j][3] * v[j][3]);
        const float r = rsqrtf(wave_sum(s) * (1.f / DM) + EPS);
        v2u* o = (v2u*)(hb + (size_t)m * DM) + lane;
#pragma unroll
        for (int j = 0; j < 4; ++j) { const int col = 4 * (lane + 64 * j);
            const f32x4 ww = *(const f32x4*)(w + col), sc = *(const f32x4*)(mb + 1024 + col), sh = *(const f32x4*)(mb + col);
            const f32x4 y = v[j] * r * ww * (sc + 1.0f) + sh;
            v2u q; q.x = pk2(y[0], y[1]); q.y = pk2(y[2], y[3]); o[64 * j] = q; }
        if constexpr (WITH_SS) {
            float* ss = (float*)(P.ws + WS_SS) + (size_t)m * 16;
#pragma unroll
            for (int j = 0; j < 4; ++j) {
                const v2u qa = qac[j], qd = qdc[j];
                const float a0 = bflo(qa.x), a1 = bfhi(qa.x), a2 = bflo(qa.y), a3 = bfhi(qa.y);
                const float d0 = bflo(qd.x), d1 = bfhi(qd.x), d2 = bflo(qd.y), d3 = bfhi(qd.y);
                float sa = (a0 * a0 + a1 * a1) + (a2 * a2 + a3 * a3), sd = (d0 * d0 + d1 * d1) + (d2 * d2 + d3 * d3);
                sa = wave_sum(sa); sd = xsum16(row16_sum(sd));
                if (lane == 0) ss[8 + j] = sa;
                if ((lane & 31) == 0) ss[2 * j + (lane >> 5)] = sd;
            }
        }
    }
}
__device__ __forceinline__ void phase_ss(const Params& P) {
    const int tid = threadIdx.x, lane = tid & 63, wave = tid >> 6;
    const int gw = blockIdx.x * 8 + wave, NGW = gridDim.x * 8;
    const bf16* oab = (const bf16*)P.out; const bf16* odb = (const bf16*)(P.ws + WS_DV);
    v2u qan[4], qdn[4];
    if (gw < T) {
#pragma unroll
        for (int j = 0; j < 4; ++j) { qan[j] = ((const v2u*)(oab + (size_t)gw * DM) + lane)[64 * j]; qdn[j] = ((const v2u*)(odb + (size_t)gw * DM) + lane)[64 * j]; }
    }
    for (int m = gw; m < T; m += NGW) {
        v2u qac[4], qdc[4];
#pragma unroll
        for (int j = 0; j < 4; ++j) { qac[j] = qan[j]; qdc[j] = qdn[j]; }
        if (m + NGW < T) { const int mn = m + NGW;
#pragma unroll
            for (int j = 0; j < 4; ++j) { qan[j] = ((const v2u*)(oab + (size_t)mn * DM) + lane)[64 * j]; qdn[j] = ((const v2u*)(odb + (size_t)mn * DM) + lane)[64 * j]; } }
        float* ss = (float*)(P.ws + WS_SS) + (size_t)m * 16;
#pragma unroll
        for (int j = 0; j < 4; ++j) {
            const v2u qa = qac[j], qd = qdc[j];
            const float a0 = bflo(qa.x), a1 = bfhi(qa.x), a2 = bflo(qa.y), a3 = bfhi(qa.y);
            const float d0 = bflo(qd.x), d1 = bfhi(qd.x), d2 = bflo(qd.y), d3 = bfhi(qd.y);
            float sa = (a0 * a0 + a1 * a1) + (a2 * a2 + a3 * a3), sd = (d0 * d0 + d1 * d1) + (d2 * d2 + d3 * d3);
            sa = wave_sum(sa); sd = xsum16(row16_sum(sd));
            if (lane == 0) ss[8 + j] = sa;
            if ((lane & 31) == 0) ss[2 * j + (lane >> 5)] = sd;
        }
    }
}
__device__ __forceinline__ void phase_row1(const Params& P) {
    const int tid = threadIdx.x, lane = tid & 63, wave = tid >> 6;
    const int gw = blockIdx.x * 8 + wave, NGW = gridDim.x * 8;
    const float* x = P.in[0]; const float* wpost = P.in[5]; const float* wpre = P.in[6]; const float* mod = (const float*)(P.ws + WS_MOD);
    const bf16* zb = (const bf16*)(P.ws + WS_Z); bf16* h2 = (bf16*)(P.ws + WS_H2);
    f32x4 vnx[4]; v2u znx[4];
    if (gw < T) {
#pragma unroll
        for (int j = 0; j < 4; ++j) { vnx[j] = ((const f32x4*)(x + (size_t)gw * DM) + lane)[64 * j]; znx[j] = ((const v2u*)(zb + (size_t)gw * DM) + lane)[64 * j]; }
    }
    for (int m = gw; m < T; m += NGW) {
        const int b = m / SEQ; const float* mb = mod + b * 6144;
        f32x4 v[4], z[4]; v2u zc[4]; float s = 0.f;
#pragma unroll
        for (int j = 0; j < 4; ++j) { v[j] = vnx[j]; zc[j] = znx[j]; }
        if (m + NGW < T) { const int mn = m + NGW;
#pragma unroll
            for (int j = 0; j < 4; ++j) { vnx[j] = ((const f32x4*)(x + (size_t)mn * DM) + lane)[64 * j]; znx[j] = ((const v2u*)(zb + (size_t)mn * DM) + lane)[64 * j]; } }
#pragma unroll
        for (int j = 0; j < 4; ++j) { const v2u q = zc[j]; z[j] = (f32x4){bflo(q.x), bfhi(q.x), bflo(q.y), bfhi(q.y)};
            s += (z[j][0] * z[j][0] + z[j][1] * z[j][1]) + (z[j][2] * z[j][2] + z[j][3] * z[j][3]); }
        const float r1 = rsqrtf(wave_sum(s) * (1.f / DM) + EPS); float s2 = 0.f;
        f32x4* orow = (f32x4*)(P.out + (size_t)m * DM) + lane;
#pragma unroll
        for (int j = 0; j < 4; ++j) { const int col = 4 * (lane + 64 * j);
            const f32x4 ww = *(const f32x4*)(wpost + col), g1 = *(const f32x4*)(mb + 2048 + col);
            v[j] = v[j] + g1 * (z[j] * r1 * ww); orow[64 * j] = v[j];
            s2 += (v[j][0] * v[j][0] + v[j][1] * v[j][1]) + (v[j][2] * v[j][2] + v[j][3] * v[j][3]); }
        const float r2 = rsqrtf(wave_sum(s2) * (1.f / DM) + EPS);
        v2u* o = (v2u*)(h2 + (size_t)m * DM) + lane;
#pragma unroll
        for (int j = 0; j < 4; ++j) { const int col = 4 * (lane + 64 * j);
            const f32x4 ww = *(const f32x4*)(wpre + col), sc = *(const f32x4*)(mb + 4096 + col), sh = *(const f32x4*)(mb + 3072 + col);
            const f32x4 y = v[j] * r2 * ww * (sc + 1.0f) + sh;
            v2u q; q.x = pk2(y[0], y[1]); q.y = pk2(y[2], y[3]); o[64 * j] = q; }
    }
}
__device__ __forceinline__ void phase_row2(const Params& P) {
    const int tid = threadIdx.x, lane = tid & 63, wave = tid >> 6;
    const int gw = blockIdx.x * 8 + wave, NGW = gridDim.x * 8;
    const float* wpost = P.in[7]; const float* mod = (const float*)(P.ws + WS_MOD);
    const bf16* yb = (const bf16*)(P.ws + WS_Y);
    f32x4 vnx[4]; v2u znx[4];
    if (gw < T) {
#pragma unroll
        for (int j = 0; j < 4; ++j) { vnx[j] = ((const f32x4*)(P.out + (size_t)gw * DM) + lane)[64 * j]; znx[j] = ((const v2u*)(yb + (size_t)gw * DM) + lane)[64 * j]; }
    }
    for (int m = gw; m < T; m += NGW) {
        const int b = m / SEQ; const float* mb = mod + b * 6144;
        f32x4* orow = (f32x4*)(P.out + (size_t)m * DM) + lane;
        f32x4 v[4], z[4]; v2u zc[4]; float s = 0.f;
#pragma unroll
        for (int j = 0; j < 4; ++j) { v[j] = vnx[j]; zc[j] = znx[j]; }
        if (m + NGW < T) { const int mn = m + NGW;
#pragma unroll
            for (int j = 0; j < 4; ++j) { vnx[j] = ((const f32x4*)(P.out + (size_t)mn * DM) + lane)[64 * j]; znx[j] = ((const v2u*)(yb + (size_t)mn * DM) + lane)[64 * j]; } }
#pragma unroll
        for (int j = 0; j < 4; ++j) { const v2u q = zc[j]; z[j] = (f32x4){bflo(q.x), bfhi(q.x), bflo(q.y), bfhi(q.y)};
            s += (z[j][0] * z[j][0] + z[j][1] * z[j][1]) + (z[j][2] * z[j][2] + z[j][3] * z[j][3]); }
        const float r1 = rsqrtf(wave_sum(s) * (1.f / DM) + EPS);
#pragma unroll
        for (int j = 0; j < 4; ++j) { const int col = 4 * (lane + 64 * j);
            const f32x4 ww = *(const f32x4*)(wpost + col), g2 = *(const f32x4*)(mb + 5120 + col);
            orow[64 * j] = v[j] + g2 * (z[j] * r1 * ww); }
    }
}

__device__ __forceinline__ v4u pack8f(const float (&v)[8]) { v4u w; w.x = pk2(v[0], v[1]); w.y = pk2(v[2], v[3]); w.z = pk2(v[4], v[5]); w.w = pk2(v[6], v[7]); return w; }
__device__ __forceinline__ void unpack8(const v4u q, float (&o)[8]) { o[0] = bflo(q.x); o[1] = bfhi(q.x); o[2] = bflo(q.y); o[3] = bfhi(q.y); o[4] = bflo(q.z); o[5] = bfhi(q.z); o[6] = bflo(q.w); o[7] = bfhi(q.w); }
#ifndef DBG_BRD_EXPR
#define DBG_BRD_EXPR (mg[e] + g[e] * v[e])
#endif
#ifndef PG8_ALIGN
#define PG8_ALIGN true
#endif
#ifndef PG8_SP2
#define PG8_SP2 true
#endif
constexpr int EPI_SSX_OFF = 131072;
enum { M_INPROJ = 0, M_GATES = 1, M_BRA = 2, M_BRD = 3, M_OUT = 4, M_MLP1 = 5, M_MLP2 = 6 };
template <int MODE> struct Epi {
    static constexpr bool PERM = true, AFTER_DRAIN = false;
    uchar* ws; const float* p0; const float* p1; uchar* ob; LAS uchar* ldsb;
    __device__ __forceinline__ void operator()(const pg8::f32x4 (&acc)[2][2][4][2], const pg8::Unit& u, int wr, int wc, int fr, int fq) const {
        const int pn = u.pn;
        LAS float* ssx = (LAS float*)(ldsb + EPI_SSX_OFF);
        if constexpr (MODE == M_GATES) {
            if (pn < 8) {
                const bf16* Ob = (const bf16*)(pn < 4 ? ob : ws + WS_DV);
#pragma unroll
                for (int ai = 0; ai < 2; ++ai)
#pragma unroll
                    for (int m = 0; m < 4; ++m)
#pragma unroll
                        for (int bj = 0; bj < 2; ++bj) {
                            const int rowl = ai * 128 + wr * 64 + m * 16 + fr, cu = bj * 128 + wc * 32 + 8 * fq;
                            float o[8]; unpack8(*(const v4u*)(Ob + (size_t)(u.pm * 256 + rowl) * 1024 + (pn & 3) * 256 + cu), o);
                            float q = ((o[0] * o[0] + o[1] * o[1]) + (o[2] * o[2] + o[3] * o[3])) + ((o[4] * o[4] + o[5] * o[5]) + (o[6] * o[6] + o[7] * o[7]));
                            q = xsum32(xsum16(q));
                            if (fq == 0) ssx[(rowl * 2 + bj) * 4 + wc] = q;
                        }
                asm volatile("s_waitcnt lgkmcnt(0)" ::: "memory"); __builtin_amdgcn_s_barrier(); asm volatile("" ::: "memory");
            }
        }
#pragma unroll
        for (int ai = 0; ai < 2; ++ai)
#pragma unroll
            for (int m = 0; m < 4; ++m) {
                const int row = u.pm * 256 + ai * 128 + wr * 64 + m * 16 + fr;
#pragma unroll
                for (int bj = 0; bj < 2; ++bj) {
                    const int cu = bj * 128 + wc * 32 + 8 * fq;
                    const pg8::f32x4 v0 = acc[ai][bj][m][0], v1 = acc[ai][bj][m][1];
                    float v[8] = {v0[0], v0[1], v0[2], v0[3], v1[0], v1[1], v1[2], v1[3]};
                    if constexpr (MODE == M_INPROJ) {
                        if (pn < 20) {
                            bf16* base; int ld, col;
                            if (pn < 2) { base = (bf16*)(ws + WS_AQ); ld = 512; col = pn * 256 + cu; }
                            else if (pn < 4) { base = (bf16*)(ws + WS_AK); ld = 512; col = (pn - 2) * 256 + cu; }
                            else { base = (bf16*)(ws + WS_AV + (size_t)((pn - 4) >> 2) * (64 * MiB)); ld = 1024; col = ((pn - 4) & 3) * 256 + cu; }
                            const v4u w = pack8f(v);
                            *(v4u*)(base + (size_t)row * ld + col) = w;
                            if (m == 3) { if (pn >= 8 && fr >= 13) { const int chunk = row >> 6, hr = (row & 63) - 61;
                                *(v4u*)((bf16*)(ws + WS_HALO) + ((size_t)chunk * 3 + hr) * 3072 + (pn - 8) * 256 + cu) = w; } }
                        } else if (bj == 0) { if (wc == 0) { float* sm = (float*)(ws + WS_SM) + (size_t)row * 32 + 8 * fq;
                            *(pg8::f32x4*)sm = v0; *(pg8::f32x4*)(sm + 4) = v1; } }
                    } else if constexpr (MODE == M_GATES) {
                        if (pn < 8) {
                            bf16* O; int col, slot; float invd; const float* ow;
                            if (pn < 4) { O = (bf16*)ob; col = pn * 256 + cu; slot = 8 + pn; invd = 1.f / 256.f; ow = p0 + cu; }
                            else { O = (bf16*)(ws + WS_DV); col = (pn - 4) * 256 + cu; slot = col >> 7; invd = 1.f / 128.f; ow = p1 + (col & 127); }
                            float ssv; { const int rowl = ai * 128 + wr * 64 + m * 16 + fr; (void)slot;
                                const pg8::f32x4 q0 = *(const LAS pg8::f32x4*)(ssx + (rowl * 2 + bj) * 4);
                                ssv = (q0[0] + q0[1]) + (q0[2] + q0[3]);
                                if (pn < 4) { const pg8::f32x4 q1 = *(const LAS pg8::f32x4*)(ssx + (rowl * 2 + (bj ^ 1)) * 4); const float s1_ = (q1[0] + q1[1]) + (q1[2] + q1[3]);
                                    ssv = bj == 0 ? ssv + s1_ : s1_ + ssv; } }
                            const float r = rsqrtf(ssv * invd + EPS);
                            bf16* op = O + (size_t)row * 1024 + col;
                            float o[8]; unpack8(*(const v4u*)op, o);
                            const pg8::f32x4 w0 = *(const pg8::f32x4*)ow, w1 = *(const pg8::f32x4*)(ow + 4);
                            const float wv[8] = {w0[0], w0[1], w0[2], w0[3], w1[0], w1[1], w1[2], w1[3]};
#pragma unroll
                            for (int e = 0; e < 8; ++e) v[e] = o[e] * r * wv[e] * siluf_(v[e]);
                            *(v4u*)op = pack8f(v);
                        } else {
                            bf16* G = (bf16*)(ws + (pn < 12 ? WS_SGA : WS_SGD)); const int col = ((pn - 8) & 3) * 256 + cu;
#pragma unroll
                            for (int e = 0; e < 8; ++e) v[e] = sigmoidf_(v[e]);
                            *(v4u*)(G + (size_t)row * 1024 + col) = pack8f(v);
                        }
                    } else if constexpr (MODE == M_BRA) {
                        const size_t off = (size_t)row * 1024 + pn * 256 + cu;
                        float g[8]; unpack8(*(const v4u*)((const bf16*)(ws + WS_SGA) + off), g);
#pragma unroll
                        for (int e = 0; e < 8; ++e) v[e] = g[e] * v[e];
                        *(v4u*)((bf16*)(ws + WS_YA) + off) = pack8f(v);
                    } else if constexpr (MODE == M_BRD) {
                        const size_t off = (size_t)row * 1024 + pn * 256 + cu;
                        float g[8], mg[8]; unpack8(*(const v4u*)((const bf16*)(ws + WS_SGD) + off), g); unpack8(*(const v4u*)((const bf16*)(ws + WS_YA) + off), mg);
#pragma unroll
                        for (int e = 0; e < 8; ++e) v[e] = DBG_BRD_EXPR;
                        *(v4u*)((bf16*)(ws + WS_MG) + off) = pack8f(v);
                    } else if constexpr (MODE == M_OUT) {
                        *(v4u*)((bf16*)(ws + WS_Z) + (size_t)row * 1024 + pn * 256 + cu) = pack8f(v);
                    } else if constexpr (MODE == M_MLP1) {
#pragma unroll
                        for (int e = 0; e < 8; ++e) { const float t = fmaxf(v[e], 0.f); v[e] = t * t; }
                        *(v4u*)((bf16*)(ws + WS_A1) + (size_t)row * 4096 + pn * 256 + cu) = pack8f(v);
                    } else {
                        *(v4u*)((bf16*)(ws + WS_Y) + (size_t)row * 1024 + pn * 256 + cu) = pack8f(v);
                    }
                }
            }
    }
};
template <int MODE>
__device__ __forceinline__ void run_gemm(LAS uchar* lds, const bf16* A, const bf16* Bt, int N, int K, uchar* ws, const float* p0, const float* p1, uchar* ob = nullptr) {
    pg8::Gemm g{A, Bt, T, N, K}; pg8::StaticOrder S; S.init(T, N, (int)gridDim.x, (int)blockIdx.x);
    Epi<MODE> E{ws, p0, p1, ob, lds};
    pg8::gemm_phase<Epi<MODE>, pg8::StaticOrder, PG8_ALIGN, PG8_SP2>((PG8_LAS unsigned char*)lds, g, S, E);
}

constexpr int LP = 136;
constexpr int PL_Q = 0, PL_K = 17408, PL_V = 34816, PL_W = 52224, PL_AM = 69632, PL_SM = 86016, PL_RAW = 86784, RAWP = 784, PL_CW = 139312, PL_EKL = 145456, PL_XU = 86784;
constexpr float QSCALE = 0.08838834764831845f;

__host__ __device__ constexpr int solve_nld(int i) { return ((i + 1) / 2 + 3) / 4; }
__host__ __device__ constexpr bool solve_group_end(int i) { int cnt = 0; bool end = false; for (int r = 0; r <= i; ++r) { cnt += solve_nld(r); end = (cnt + solve_nld(r + 1) > 12); if (end) cnt = 0; } return end; }
#ifndef DBG_SOLVE_LIM
#define DBG_SOLVE_LIM(x) (x)
#endif
__device__ __forceinline__ uchar* reg_addr(uchar* base, int pitch, int q) { return base + (size_t)(q >> 8) * pitch + (q & 255); }

template <bool GDN>
__device__ __forceinline__ void att_frag(LAS uchar* lds, int wave, int lane, const LAS float* gc, bf16* attdst) {
    const int ntq = wave >> 1, kt2 = wave & 1, c = lane & 15, rq = lane >> 4;
    f32x4 d[2];
#pragma unroll
    for (int hh = 0; hh < 2; ++hh) {
        const int mtk = 2 * kt2 + hh; f32x4 acc = {0.f, 0.f, 0.f, 0.f};
#pragma unroll
        for (int kt = 0; kt < 4; ++kt) {
            const bf16x8 a = *(const LAS bf16x8*)(lds + PL_K + ((16 * mtk + c) * LP + 32 * kt + 8 * rq) * 2);
            const bf16x8 b = *(const LAS bf16x8*)(lds + PL_Q + ((16 * ntq + c) * LP + 32 * kt + 8 * rq) * 2);
            acc = MFMA16(a, b, acc);
        }
        const int i = 16 * ntq + c;
#pragma unroll
        for (int jj = 0; jj < 4; ++jj) { const int jp = 16 * mtk + 4 * rq + jj;
            float val = acc[jj];
            if (GDN) val *= QSCALE * __expf(gc[i] - gc[jp]);
            acc[jj] = (jp <= i) ? val : 0.f; }
        d[hh] = acc;
    }
    *(bf16x8*)(attdst + ((ntq * 2 + kt2) * 64 + lane) * 8) = pack8(d[0], d[1]);
}

__device__ __forceinline__ void gdn_load_raw(const Params& P, int item, v4u (&rawv)[7], float& sm_b, float& sm_a) {
    const int tid = threadIdx.x, lane = tid & 63, wave = tid >> 6;
    const int b = item >> 11, n = (item >> 3) & 255, h = item & 7, t0 = b * SEQ + n * 64;
    const uchar* ws = P.ws; const bf16* halo = (const bf16*)(ws + WS_HALO);
    if (wave == 0) { const float* sm = (const float*)(ws + WS_SM) + (size_t)(t0 + lane) * 32; sm_b = sm[16 + h]; sm_a = sm[24 + h]; }
#pragma unroll
    for (int e = 0; e < 7; ++e) {
        const int p = tid + 512 * e; const int r = p / 48, pc = p - r * 48, z = pc >> 4, gq = pc & 15, ri = r - 3;
        v4u xv = {0u, 0u, 0u, 0u};
        if (p < 67 * 48) {
            if (ri >= 0) xv = *(const v4u*)((const bf16*)(ws + WS_DQ + (size_t)z * (64 * MiB)) + (size_t)(t0 + ri) * 1024 + h * 128 + gq * 8);
            else if (n > 0) xv = *(const v4u*)(halo + ((size_t)(b * NCHK + n - 1) * 3 + r) * 3072 + z * 1024 + h * 128 + gq * 8);
        }
        rawv[e] = xv;
    }
}
__device__ __forceinline__ void prep_gdn(const Params& P, LAS uchar* lds, int item, int next_item, v4u (&rawv)[7], float& sm_b, float& sm_a) {
    const int tid = threadIdx.x, lane = tid & 63, wave = tid >> 6;
    const int b = item >> 11, n = (item >> 3) & 255, h = item & 7;
    const int t0 = b * SEQ + n * 64;
    uchar* ws = P.ws;
    LAS float* beta = (LAS float*)(lds + PL_SM); LAS float* gc = beta + 64; LAS float* eg = beta + 128;
    {
#pragma unroll
        for (int e = 0; e < 7; ++e) { const int p = tid + 512 * e; const int r = p / 48, pc = p - r * 48;
            if (p < 67 * 48) *(LAS v4u*)(lds + PL_RAW + r * RAWP + pc * 16) = rawv[e]; }
        __syncthreads();
        const LAS float* cwl = (const LAS float*)(lds + PL_CW);
#pragma unroll
        for (int e = 0; e < 6; ++e) {
            const int z = e >> 1, i = (tid >> 4) + 32 * (e & 1), gq = tid & 15;
            float y[8] = {0.f, 0.f, 0.f, 0.f, 0.f, 0.f, 0.f, 0.f};
#pragma unroll
            for (int jr = 0; jr < 4; ++jr) {
                const v4u xv = *(const LAS v4u*)(lds + PL_RAW + (i + jr) * RAWP + (z * 16 + gq) * 16);
                float xf[8]; unpack8(xv, xf);
                const f32x4 w0 = *(const LAS f32x4*)(cwl + jr * 384 + z * 128 + gq * 8), w1 = *(const LAS f32x4*)(cwl + jr * 384 + z * 128 + gq * 8 + 4);
                y[0] += w0[0] * xf[0]; y[1] += w0[1] * xf[1]; y[2] += w0[2] * xf[2]; y[3] += w0[3] * xf[3];
                y[4] += w1[0] * xf[4]; y[5] += w1[1] * xf[5]; y[6] += w1[2] * xf[6]; y[7] += w1[3] * xf[7];
            }
            float ssq = 0.f;
#pragma unroll
            for (int k = 0; k < 8; ++k) { y[k] = siluf_(y[k]); ssq += y[k] * y[k]; }
            if (z < 2) {
                ssq = row16_sum(ssq);
                const float r = rsqrtf(ssq + EPS);
#pragma unroll
                for (int k = 0; k < 8; ++k) y[k] *= r;
            }
            v4u o; o.x = pk2(y[0], y[1]); o.y = pk2(y[2], y[3]); o.z = pk2(y[4], y[5]); o.w = pk2(y[6], y[7]);
            *(LAS v4u*)(lds + z * 17408 + (i * LP + gq * 8) * 2) = o;
        }
    }
    if (wave == 0) {
        const float bt = sigmoidf_(sm_b);
        float g = -__expf(P.in[13][h]) * softplusf_(sm_a + P.in[14][h]);
#pragma unroll
        for (int o = 1; o < 64; o <<= 1) { const float t = __shfl_up(g, o); if (lane >= o) g += t; }
        beta[lane] = bt; gc[lane] = g; eg[lane] = __expf(g);
        const float gl = __shfl(g, 63); ((LAS float*)(lds + PL_EKL))[lane] = __expf(gl - g);
    }
    __syncthreads();
    const float glast = gc[63];
    {
        const int c = lane & 15, rq = lane >> 4, mt = wave >> 1;
        LAS float* am = (LAS float*)(lds + PL_AM);
#pragma unroll
        for (int hh = 0; hh < 2; ++hh) {
            const int nt = 2 * (wave & 1) + hh; f32x4 acc = {0.f, 0.f, 0.f, 0.f};
#pragma unroll
            for (int kt = 0; kt < 4; ++kt) {
                const bf16x8 a = *(const LAS bf16x8*)(lds + PL_K + ((16 * mt + c) * LP + 32 * kt + 8 * rq) * 2);
                const bf16x8 bb = *(const LAS bf16x8*)(lds + PL_K + ((16 * nt + c) * LP + 32 * kt + 8 * rq) * 2);
                acc = MFMA16(a, bb, acc);
            }
            const int j = 16 * nt + c;
#pragma unroll
            for (int jj = 0; jj < 4; ++jj) { const int i = 16 * mt + 4 * rq + jj;
                am[i * 64 + (j & 1) * 32 + (j >> 1)] = (j < i) ? beta[i] * acc[jj] * __expf(gc[i] - gc[j]) : 0.f; }
        }
        att_frag<true>(lds, wave, lane, gc, (bf16*)(ws + WS_ATTD) + ((size_t)(b * NCHK + n) * 8 + h) * 4096);
    }
    __syncthreads();
    uchar* rQ = ws + WS_DQ + ((size_t)t0 * 1024 + h * 128) * 2;
    uchar* rK = ws + WS_DK + ((size_t)t0 * 1024 + h * 128) * 2;
    uchar* rU = ws + WS_DV + ((size_t)t0 * 1024 + h * 128) * 2;
    {
        const int cc = wave * 32 + (lane & 31), p = lane >> 5;
        const LAS bf16* colp = (const LAS bf16*)(lds + (cc < 128 ? PL_V : PL_K)) + (cc & 127);
        int vzero; asm volatile("v_mov_b32 %0, 0" : "=v"(vzero));
        const LAS float* betav = beta + vzero; const LAS float* egv = eg + vzero;
        const LAS float* am = (const LAS float*)(lds + PL_AM) + vzero + p * 32;
        float xo[32];
#pragma unroll
        for (int k = 0; k < 32; ++k) xo[k] = 0.f;
        LAS bf16* xt = (LAS bf16*)(lds + (cc < 128 ? PL_XU : PL_W)) + (cc & 127);
        const float sgn = (cc < 128) ? 1.f : -1.f;
#pragma unroll
        for (int i = 0; i < 64; ++i) {
            float rhs = betav[i] * bf2f(colp[i * LP]); if (cc >= 128) rhs *= egv[i];
            float ac[4] = {0.f, 0.f, 0.f, 0.f};
            constexpr int dummy = 0; (void)dummy;
            const int nj = (i + 1) / 2;
#pragma unroll
            for (int j4 = 0; j4 < DBG_SOLVE_LIM((nj + 3) / 4); ++j4) {
                const f32x4 a = *(const LAS f32x4*)(am + i * 64 + 4 * j4);
#pragma unroll
                for (int e = 0; e < 4; ++e) if (4 * j4 + e < nj) ac[e] += a[e] * xo[4 * j4 + e];
            }
            float tot = (ac[0] + ac[1]) + (ac[2] + ac[3]);
            if (i > 0) tot = xsum32(tot);
            const float xi = rhs - tot;
            if (p == (i & 1)) { xo[i >> 1] = xi; xt[i * LP] = (bf16)f2bf(sgn * xi); }
            if (solve_group_end(i)) asm volatile("" ::: "memory");
        }
    }
    __syncthreads();
    if (next_item < 4096) gdn_load_raw(P, next_item, rawv, sm_b, sm_a);
    {
#pragma unroll
        for (int e = 0; e < 2; ++e) {
            const int fl = tid + 512 * e, mt = fl >> 8, kt = (fl >> 6) & 3, r = fl & 15, kq = (fl >> 4) & 3, i = 16 * mt + r;
            const v2u a = *(const LAS v2u*)(lds + PL_Q + (i * LP + 32 * kt + 4 * kq) * 2), bq = *(const LAS v2u*)(lds + PL_Q + (i * LP + 32 * kt + 16 + 4 * kq) * 2);
            const float f = QSCALE * eg[i];
            v4u o; o.x = pk2(bflo(a.x) * f, bfhi(a.x) * f); o.y = pk2(bflo(a.y) * f, bfhi(a.y) * f); o.z = pk2(bflo(bq.x) * f, bfhi(bq.x) * f); o.w = pk2(bflo(bq.y) * f, bfhi(bq.y) * f);
            *(v4u*)reg_addr(rQ, 2048, fl * 16) = o;
        }
#pragma unroll
        for (int e = 0; e < 2; ++e) {
            const int fl = tid + 512 * e, mt8 = fl >> 7, kt2 = (fl >> 6) & 1, r = fl & 15, kq = (fl >> 4) & 3, d = 16 * mt8 + r;
            float vv[8];
#pragma unroll
            for (int s = 0; s < 8; ++s) { const int j = 32 * kt2 + (s < 4 ? 4 * kq + s : 16 + 4 * kq + s - 4);
                vv[s] = bf2f(((const LAS bf16*)(lds + PL_K))[j * LP + d]) * ((const LAS float*)(lds + PL_EKL))[j]; }
            v4u o; o.x = pk2(vv[0], vv[1]); o.y = pk2(vv[2], vv[3]); o.z = pk2(vv[4], vv[5]); o.w = pk2(vv[6], vv[7]);
            *(v4u*)reg_addr(rK, 2048, fl * 16) = o;
        }
        if (tid < 128) ((float*)(ws + WS_DEC))[((size_t)(b * NCHK + n) * 12 + h) * 128 + tid] = __expf(glast);
#pragma unroll
        for (int e = 0; e < 4; ++e) {
            const int it = tid + 512 * e, sl = it >> 8, mt = (it >> 6) & 3, ln = it & 63, c = ln & 15, rq = ln >> 4;
            const LAS bf16* up = (const LAS bf16*)(lds + PL_XU) + (16 * mt + 4 * rq) * LP + sl * 16 + c;
            v2u o; o.x = (unsigned)up[0] | ((unsigned)up[LP] << 16); o.y = (unsigned)up[2 * LP] | ((unsigned)up[3 * LP] << 16);
            { const int q_ = (((sl & 3) * 4 + mt) * 64 + ln) * 8; *(v2u*)(rU + (size_t)(q_ >> 7) * 2048 + (sl >> 2) * 128 + (q_ & 127)) = o; }
        }
        bf16* wdst = (bf16*)((uchar*)P.out + 64 * MiB) + ((size_t)(b * NCHK + n) * 8 + h) * 8192;
#pragma unroll
        for (int e = 0; e < 2; ++e) {
            const int fl = tid + 512 * e, mt = fl >> 8, kt = (fl >> 6) & 3, r = fl & 15, kq = (fl >> 4) & 3, i = 16 * mt + r;
            const v2u a = *(const LAS v2u*)(lds + PL_W + (i * LP + 32 * kt + 4 * kq) * 2), bq = *(const LAS v2u*)(lds + PL_W + (i * LP + 32 * kt + 16 + 4 * kq) * 2);
            v4u o; o.x = a.x; o.y = a.y; o.z = bq.x; o.w = bq.y;
            *(v4u*)(wdst + fl * 8) = o;
        }
    }
    __syncthreads();
}

constexpr int GL_V = 34816, GL_ALR = 68608, GL_BQ = 72704, GL_BL = 74752, VP = 264;
struct GlaRaw { v4u v[4]; f32x4 alr; unsigned short q[16], k[16]; };
__device__ __forceinline__ void gla_load_raw(const Params& P, int item, GlaRaw& R) {
    const int tid = threadIdx.x;
    const int b = item >> 10, n = (item >> 2) & 255, h = item & 3, t0 = b * SEQ + n * 64;
    const uchar* ws = P.ws;
    if (tid < 256) { const int i = tid >> 2, r4 = (tid & 3) * 4; R.alr = *(const f32x4*)((const float*)(ws + WS_SM) + (size_t)(t0 + i) * 32 + r4); }
#pragma unroll
    for (int e = 0; e < 4; ++e) { const int p = tid + 512 * e, i = p >> 5, g8 = p & 31;
        R.v[e] = *(const v4u*)((const bf16*)(ws + WS_AV) + (size_t)(t0 + i) * 1024 + h * 256 + g8 * 8); }
    const int d = tid & 127, qt = tid >> 7;
    const bf16* aq = (const bf16*)(ws + WS_AQ) + (size_t)(t0 + 16 * qt) * 512 + h * 128 + d;
    const bf16* ak = (const bf16*)(ws + WS_AK) + (size_t)(t0 + 16 * qt) * 512 + h * 128 + d;
#pragma unroll
    for (int ii = 0; ii < 16; ++ii) { R.q[ii] = aq[(size_t)ii * 512]; R.k[ii] = ak[(size_t)ii * 512]; }
}
__device__ __forceinline__ void prep_gla(const Params& P, LAS uchar* lds, int item, int next_item, GlaRaw& R, const float (&wl)[16], float bias) {
    const int tid = threadIdx.x, lane = tid & 63, wave = tid >> 6;
    const int b = item >> 10, n = (item >> 2) & 255, h = item & 3;
    const int t0 = b * SEQ + n * 64;
    uchar* ws = P.ws;
    LAS float* alr = (LAS float*)(lds + GL_ALR); LAS float* bqs = (LAS float*)(lds + GL_BQ); LAS float* bl = (LAS float*)(lds + GL_BL);
    if (tid < 256) { const int i = tid >> 2, r4 = (tid & 3) * 4; *(LAS f32x4*)(alr + i * 16 + r4) = R.alr; }
#pragma unroll
    for (int e = 0; e < 4; ++e) { const int p = tid + 512 * e, i = p >> 5, g8 = p & 31; *(LAS v4u*)(lds + GL_V + (i * VP + g8 * 8) * 2) = R.v[e]; }
    __syncthreads();
    const int d = tid & 127, qt = tid >> 7;
    float bloc[16];
    {
        float run = 0.f;
#pragma unroll
        for (int ii = 0; ii < 16; ++ii) { const int i = 16 * qt + ii; float z = bias;
#pragma unroll
            for (int r4 = 0; r4 < 4; ++r4) { const f32x4 a = *(const LAS f32x4*)(alr + i * 16 + 4 * r4);
                z += a[0] * wl[4 * r4] + a[1] * wl[4 * r4 + 1] + a[2] * wl[4 * r4 + 2] + a[3] * wl[4 * r4 + 3]; }
            run += -softplusf_(-z) * (1.f / 16.f); bloc[ii] = run; }
        bqs[qt * 128 + d] = run;
    }
    __syncthreads();
    {
        float off = 0.f, tot = 0.f;
#pragma unroll
        for (int q = 0; q < 4; ++q) { const float t = bqs[q * 128 + d]; if (q < qt) off += t; tot += t; }
#pragma unroll
        for (int ii = 0; ii < 16; ++ii) { const int i = 16 * qt + ii; const float bi = off + bloc[ii];
            const float qv = bf2f(R.q[ii]) * QSCALE * __expf(bi), kv = bf2f(R.k[ii]) * __expf(-bi);
            ((LAS bf16*)(lds + PL_Q))[i * LP + d] = (bf16)f2bf(qv); ((LAS bf16*)(lds + PL_K))[i * LP + d] = (bf16)f2bf(kv); }
        if (qt == 0) { bl[d] = tot; ((float*)(ws + WS_DEC))[((size_t)(b * NCHK + n) * 12 + 8 + h) * 128 + d] = __expf(tot); }
    }
    __syncthreads();
    if (next_item < 2048) gla_load_raw(P, next_item, R);
    att_frag<false>(lds, wave, lane, nullptr, (bf16*)(ws + WS_ATTA) + ((size_t)(b * NCHK + n) * 4 + h) * 4096);
    uchar* rQ = ws + WS_AQ + ((size_t)t0 * 512 + h * 128) * 2;
    uchar* rK = ws + WS_AK + ((size_t)t0 * 512 + h * 128) * 2;
#pragma unroll
    for (int e = 0; e < 2; ++e) {
        const int fl = tid + 512 * e, mt = fl >> 8, kt = (fl >> 6) & 3, r = fl & 15, kq = (fl >> 4) & 3, i = 16 * mt + r;
        const v2u a = *(const LAS v2u*)(lds + PL_Q + (i * LP + 32 * kt + 4 * kq) * 2), bq = *(const LAS v2u*)(lds + PL_Q + (i * LP + 32 * kt + 16 + 4 * kq) * 2);
        v4u o; o.x = a.x; o.y = a.y; o.z = bq.x; o.w = bq.y;
        *(v4u*)reg_addr(rQ, 1024, fl * 16) = o;
    }
#pragma unroll
    for (int e = 0; e < 2; ++e) {
        const int fl = tid + 512 * e, mt8 = fl >> 7, kt2 = (fl >> 6) & 1, r = fl & 15, kq = (fl >> 4) & 3, dd = 16 * mt8 + r;
        const float f = __expf(bl[dd]); float vv[8];
#pragma unroll
        for (int s = 0; s < 8; ++s) { const int j = 32 * kt2 + (s < 4 ? 4 * kq + s : 16 + 4 * kq + s - 4);
            vv[s] = bf2f(((const LAS bf16*)(lds + PL_K))[j * LP + dd]) * f; }
        v4u o; o.x = pk2(vv[0], vv[1]); o.y = pk2(vv[2], vv[3]); o.z = pk2(vv[4], vv[5]); o.w = pk2(vv[6], vv[7]);
        *(v4u*)reg_addr(rK, 1024, fl * 16) = o;
    }
#pragma unroll
    for (int e = 0; e < 8; ++e) {
        const int it = tid + 512 * e, g = it >> 11, sl = (it >> 8) & 7, mt = (it >> 6) & 3, ln = it & 63, c = ln & 15, rq = ln >> 4;
        const LAS bf16* vp = (const LAS bf16*)(lds + GL_V) + (16 * mt + 4 * rq) * VP + g * 128 + sl * 16 + c;
        v2u o; o.x = (unsigned)vp[0] | ((unsigned)vp[VP] << 16); o.y = (unsigned)vp[2 * VP] | ((unsigned)vp[3 * VP] << 16);
        uchar* rU = ws + WS_AV + ((size_t)t0 * 1024 + h * 256 + g * 128) * 2;
        *(v2u*)reg_addr(rU, 2048, ((sl * 4 + mt) * 64 + ln) * 8) = o;
    }
    __syncthreads();
}

constexpr int SC_W = 0, SC_Q = 16384, SC_K = 32768, SC_A = 49152, SC_U = 57344, SC_D = 65536, SC_BUF = 66048;
constexpr int SC_PF_DEPTH = 6;
struct ScStage { v4u w[2], q[2], k[2], u, a, d; };
__device__ __forceinline__ void phase_scan(const Params& P, LAS uchar* lds) {
    const int su = blockIdx.x & 63, pfk = ((int)blockIdx.x >> 6) - 1;
    const int tid = threadIdx.x, lane = tid & 63, s = tid >> 6, c = lane & 15, rq = lane >> 4;
    const bool gdn = su < 32;
    int b, h, g = 0, gh; if (gdn) { gh = su >> 4; b = (su >> 3) & 1; h = su & 7; } else { const int v = su - 32, q = v >> 3; g = q >> 1; gh = q & 1; b = (v >> 2) & 1; h = v & 3; }
    uchar* ws = P.ws;
    const uchar *pW, *pQ, *pK, *pA, *pD, *pU; uchar* pO; size_t sW, sQ, sA; int pitchQ, slot;
    if (gdn) {
        pW = (const uchar*)P.out + 64 * MiB + ((size_t)(b * NCHK) * 8 + h) * 16384; sW = 8 * 16384;
        pQ = ws + WS_DQ + ((size_t)(b * SEQ) * 1024 + h * 128) * 2; pK = ws + WS_DK + ((size_t)(b * SEQ) * 1024 + h * 128) * 2; pitchQ = 2048; sQ = 64 * 2048;
        pU = ws + WS_DV + ((size_t)(b * SEQ) * 1024 + h * 128) * 2;
        pO = ws + WS_DV + ((size_t)(b * SEQ) * 1024 + h * 128) * 2;
        pA = ws + WS_ATTD + ((size_t)(b * NCHK) * 8 + h) * 8192; sA = 8 * 8192; slot = h;
    } else {
        pW = nullptr; sW = 0;
        pQ = ws + WS_AQ + ((size_t)(b * SEQ) * 512 + h * 128) * 2; pK = ws + WS_AK + ((size_t)(b * SEQ) * 512 + h * 128) * 2; pitchQ = 1024; sQ = 64 * 1024;
        pU = ws + WS_AV + ((size_t)(b * SEQ) * 1024 + h * 256 + g * 128) * 2;
        pO = (uchar*)P.out + ((size_t)(b * SEQ) * 1024 + h * 256 + g * 128) * 2;
        pA = ws + WS_ATTA + ((size_t)(b * NCHK) * 4 + h) * 8192; sA = 4 * 8192; slot = 8 + h;
    }
    const size_t sU = 64 * 2048, sD = 12 * 512;
    pD = ws + WS_DEC + ((size_t)(b * NCHK) * 12 + slot) * 512;
    const unsigned ooff = (unsigned)(4 * rq * 1024 + gh * 64 + 16 * (s & 3) + c);
    unsigned* prog = (unsigned*)(ws + WS_PROG) + su * 64;
    if (pfk >= 0) {
        const int npf = ((int)gridDim.x >> 6) - 1;
        for (int n = pfk; n < NCHK; n += npf) {
            if (n > SC_PF_DEPTH) { int spins = 0;
                while ((int)__hip_atomic_load(prog, __ATOMIC_RELAXED, __HIP_MEMORY_SCOPE_AGENT) < n - SC_PF_DEPTH && ++spins < (1 << 18)) __builtin_amdgcn_s_sleep(8); }
            const uchar* a0; const int q = tid & 127;
            if (tid < 128) a0 = gdn ? pW + (size_t)n * sW + q * 128 : pA + (size_t)n * sA + (q & 63) * 128;
            else if (tid < 256) a0 = pQ + (size_t)n * sQ + (size_t)(q >> 1) * pitchQ + (q & 1) * 128;
            else if (tid < 384) a0 = pK + (size_t)n * sQ + (size_t)(q >> 1) * pitchQ + (q & 1) * 128;
            else a0 = gdn ? pU + (size_t)n * sU + (size_t)(q & 63) * 2048 + gh * 128 : pU + (size_t)n * sU + (size_t)(gh * 32 + ((q & 63) >> 1)) * 2048 + (q & 1) * 128;
            (void)*(const volatile unsigned*)a0;
            if (tid < 64) (void)*(const volatile unsigned*)(pA + (size_t)n * sA + tid * 128);
            else if (tid < 68) (void)*(const volatile unsigned*)(pD + (size_t)n * sD + (tid - 64) * 128);
        }
        return;
    }
    const v4u z4 = {0u, 0u, 0u, 0u};
#define SC_LOAD(R, n) do { \
        if (gdn) { R.w[0] = *(const v4u*)(pW + (size_t)(n) * sW + tid * 16); R.w[1] = *(const v4u*)(pW + (size_t)(n) * sW + (tid + 512) * 16); } \
        _Pragma("unroll") for (int e_ = 0; e_ < 2; ++e_) { const int i_ = tid + 512 * e_; \
            R.q[e_] = *(const v4u*)(pQ + (size_t)(n) * sQ + (size_t)(i_ >> 4) * pitchQ + (i_ & 15) * 16); \
            R.k[e_] = *(const v4u*)(pK + (size_t)(n) * sQ + (size_t)(i_ >> 4) * pitchQ + (i_ & 15) * 16); \
        } \
        R.u = *(const v4u*)(pU + (size_t)(n) * sU + (size_t)(gh * 32 + (tid >> 4)) * 2048 + (tid & 15) * 16); \
        R.a = *(const v4u*)(pA + (size_t)(n) * sA + tid * 16); \
        if (tid < 32) R.d = *(const v4u*)(pD + (size_t)(n) * sD + tid * 16); \
    } while (0)
#define SC_STORE(R, buf) do { LAS uchar* l_ = lds + (buf) * SC_BUF; \
        *(LAS v4u*)(l_ + SC_W + tid * 16) = R.w[0]; *(LAS v4u*)(l_ + SC_W + (tid + 512) * 16) = R.w[1]; \
        *(LAS v4u*)(l_ + SC_Q + tid * 16) = R.q[0]; *(LAS v4u*)(l_ + SC_Q + (tid + 512) * 16) = R.q[1]; \
        *(LAS v4u*)(l_ + SC_K + tid * 16) = R.k[0]; *(LAS v4u*)(l_ + SC_K + (tid + 512) * 16) = R.k[1]; \
        *(LAS v4u*)(l_ + SC_U + tid * 16) = R.u; \
        *(LAS v4u*)(l_ + SC_A + tid * 16) = R.a; \
        if (tid < 32) *(LAS v4u*)(l_ + SC_D + tid * 16) = R.d; \
    } while (0)
    f32x4 S[8];
#pragma unroll
    for (int i = 0; i < 8; ++i) S[i] = (f32x4){0.f, 0.f, 0.f, 0.f};
#define LDF(dst, off, i0) do { _Pragma("unroll") for (int i_ = 0; i_ < 8; ++i_) dst[i_] = *(const LAS bf16x8*)(L + (off) + (((i0) + i_) * 64 + lane) * 16); } while (0)
#define SC_STEP(n, buf) do { \
        const LAS uchar* L = lds + (buf) * SC_BUF; \
        bf16x8 fa[8], fb[8]; \
        v2u uu[4]; \
        _Pragma("unroll") for (int mt = 0; mt < 4; ++mt) uu[mt] = *(const LAS v2u*)(L + SC_U + (((s & 3) * 4 + mt) * 64 + lane) * 8); \
        if (gdn) { LDF(fa, SC_W, 0); LDF(fb, SC_W, 8); } else { LDF(fa, SC_Q, 0); LDF(fb, SC_Q, 8); } \
        bf16x8 Sb[4]; \
        _Pragma("unroll") for (int kt = 0; kt < 4; ++kt) Sb[kt] = pack8(S[2 * kt], S[2 * kt + 1]); \
        f32x4 vn[4]; \
        _Pragma("unroll") for (int mt = 0; mt < 4; ++mt) vn[mt] = (f32x4){bflo(uu[mt].x), bfhi(uu[mt].x), bflo(uu[mt].y), bfhi(uu[mt].y)}; \
        if (gdn) { \
            _Pragma("unroll") for (int mt = 0; mt < 2; ++mt) _Pragma("unroll") for (int kt = 0; kt < 4; ++kt) vn[mt] = MFMA16(fa[mt * 4 + kt], Sb[kt], vn[mt]); \
            LDF(fa, SC_Q, 0); \
            _Pragma("unroll") for (int mt = 0; mt < 2; ++mt) _Pragma("unroll") for (int kt = 0; kt < 4; ++kt) vn[2 + mt] = MFMA16(fb[mt * 4 + kt], Sb[kt], vn[2 + mt]); \
            LDF(fb, SC_Q, 8); \
        } \
        f32x4 o[4]; \
        _Pragma("unroll") for (int mt = 0; mt < 4; ++mt) o[mt] = (f32x4){0.f, 0.f, 0.f, 0.f}; \
        _Pragma("unroll") for (int mt = 0; mt < 2; ++mt) _Pragma("unroll") for (int kt = 0; kt < 4; ++kt) o[mt] = MFMA16(fa[mt * 4 + kt], Sb[kt], o[mt]); \
        LDF(fa, SC_A, 0); \
        _Pragma("unroll") for (int mt = 0; mt < 2; ++mt) _Pragma("unroll") for (int kt = 0; kt < 4; ++kt) o[2 + mt] = MFMA16(fb[mt * 4 + kt], Sb[kt], o[2 + mt]); \
        LDF(fb, SC_K, 0); \
        bf16x8 vb[2]; vb[0] = pack8(vn[0], vn[1]); vb[1] = pack8(vn[2], vn[3]); \
        f32x4 dvv[8]; \
        _Pragma("unroll") for (int m8 = 0; m8 < 8; ++m8) dvv[m8] = *(const LAS f32x4*)(L + SC_D + (16 * m8 + 4 * rq) * 4); \
        _Pragma("unroll") for (int mt = 0; mt < 4; ++mt) _Pragma("unroll") for (int k2 = 0; k2 < 2; ++k2) o[mt] = MFMA16(fa[mt * 2 + k2], vb[k2], o[mt]); \
        LDF(fa, SC_K, 8); \
        _Pragma("unroll") for (int m8 = 0; m8 < 4; ++m8) { f32x4 acc = S[m8] * dvv[m8]; \
            _Pragma("unroll") for (int k2 = 0; k2 < 2; ++k2) acc = MFMA16(fb[m8 * 2 + k2], vb[k2], acc); \
            S[m8] = acc; } \
        _Pragma("unroll") for (int m8 = 0; m8 < 4; ++m8) { f32x4 acc = S[4 + m8] * dvv[4 + m8]; \
            _Pragma("unroll") for (int k2 = 0; k2 < 2; ++k2) acc = MFMA16(fa[m8 * 2 + k2], vb[k2], acc); \
            S[4 + m8] = acc; } \
        { bf16* ob = (bf16*)(pO + (size_t)(n) * sU) + ooff; \
          _Pragma("unroll") for (int mt = 0; mt < 4; ++mt) { const unsigned p01 = pk2(o[mt][0], o[mt][1]), p23 = pk2(o[mt][2], o[mt][3]); \
                ob[(16 * mt + 0) * 1024] = (bf16)p01; ob[(16 * mt + 1) * 1024] = (bf16)(p01 >> 16); ob[(16 * mt + 2) * 1024] = (bf16)p23; ob[(16 * mt + 3) * 1024] = (bf16)(p23 >> 16); } } \
    } while (0)

#define SC_DMA(n, buf) do { \
        LAS uchar* l_ = lds + (buf) * SC_BUF + dma_l0; const uchar* g_ = dma_g0 + (size_t)(n) * dma_sn; \
        if (dma_on) { \
            _Pragma("unroll 1") for (int j_ = 0; j_ < 8; ++j_) { __builtin_amdgcn_global_load_lds((const unsigned*)g_, (LAS unsigned*)l_, 16, 0, 0); g_ += dma_sj; l_ += 1024; } \
            const uchar* g2_ = dma_g1 + (size_t)(n) * dma_sn1; \
            _Pragma("unroll 1") for (int j_ = 0; j_ < 8; ++j_) { __builtin_amdgcn_global_load_lds((const unsigned*)g2_, (LAS unsigned*)l_, 16, 0, 0); g2_ += dma_sj1; l_ += 1024; } \
            if (s == 7 && lane < 32) __builtin_amdgcn_global_load_lds((const unsigned*)(pD + (size_t)(n) * sD + lane * 16), (LAS unsigned*)(lds + (buf) * SC_BUF + SC_D), 16, 0, 0); \
        } \
    } while (0)
    const uchar *dma_g0 = nullptr, *dma_g1 = nullptr; size_t dma_sn = 0, dma_sn1 = 0; int dma_sj = 0, dma_sj1 = 0, dma_l0 = 0; bool dma_on = false;
    if (s == 4) { dma_on = gdn; dma_g0 = pW + lane * 16; dma_sn = sW; dma_sj = 1024; dma_g1 = dma_g0 + 8192; dma_sn1 = sW; dma_sj1 = 1024; dma_l0 = SC_W; }
    else if (s == 5 || s == 6) { const uchar* bs = (s == 5 ? pQ : pK) + (size_t)(lane >> 4) * pitchQ + (lane & 15) * 16;
        dma_on = true; dma_g0 = bs; dma_sn = sQ; dma_sj = 4 * pitchQ; dma_g1 = bs + (size_t)32 * pitchQ; dma_sn1 = sQ; dma_sj1 = 4 * pitchQ; dma_l0 = (s == 5 ? SC_Q : SC_K); }
    else if (s == 7) { dma_on = true; dma_g0 = pA + lane * 16; dma_sn = sA; dma_sj = 1024;
        if (gdn) { dma_g1 = pU + (size_t)(lane >> 3) * 2048 + gh * 128 + (lane & 7) * 16; dma_sj1 = 8 * 2048; }
        else { dma_g1 = pU + (size_t)(gh * 32 + (lane >> 4)) * 2048 + (lane & 15) * 16; dma_sj1 = 4 * 2048; }
        dma_sn1 = sU; dma_l0 = SC_A; }
    if (s >= 4) { SC_DMA(0, 0); asm volatile("s_waitcnt vmcnt(0)" ::: "memory"); }
    else if (!gdn) { const v4u zz = {0u, 0u, 0u, 0u}; for (int i = tid; i < 1024; i += 256) { *(LAS v4u*)(lds + SC_W + i * 16) = zz; *(LAS v4u*)(lds + SC_BUF + SC_W + i * 16) = zz; } }
    __syncthreads();
    for (int n = 0; n < NCHK; n += 2) {
        if (tid == 0) __hip_atomic_store(prog, (unsigned)n, __ATOMIC_RELAXED, __HIP_MEMORY_SCOPE_AGENT);
        if (s < 4) SC_STEP(n, 0); else { SC_DMA(n + 1, 1); asm volatile("s_waitcnt vmcnt(0)" ::: "memory"); }
        __syncthreads();
        if (s < 4) SC_STEP(n + 1, 1); else { if (n + 2 < NCHK) SC_DMA(n + 2, 0); asm volatile("s_waitcnt vmcnt(0)" ::: "memory"); }
        __syncthreads();
    }
#undef SC_DMA
#undef LDF
#undef SC_LOAD
#undef SC_STORE
#undef SC_STEP
}

#ifndef DBG_BRD_A
#define DBG_BRD_A 0
#endif
#ifndef DBG_BRD_B
#define DBG_BRD_B WS_WBD
#endif
#ifndef PREP_MASK
#define PREP_MASK 3
#endif
__device__ __forceinline__ void phase_prep(const Params& P, LAS uchar* lds) {
        if (PREP_MASK & 1) { int hcur = -1; bool first_ = true; v4u rawv[7]; float sm_b = 0.f, sm_a = 0.f;
            for (int it = blockIdx.x; it < 4096; it += gridDim.x) {
                if ((it & 7) != hcur) { hcur = it & 7; __syncthreads();
                    for (int i = threadIdx.x; i < 1536; i += 512) { const int jr = i / 384, rr = i - jr * 384;
                        ((LAS float*)(lds + PL_CW))[i] = P.in[12][jr * 3072 + (rr >> 7) * 1024 + hcur * 128 + (rr & 127)]; }
                    __syncthreads(); }
                if (first_) { gdn_load_raw(P, it, rawv, sm_b, sm_a); first_ = false; }
                prep_gdn(P, lds, it, it + (int)gridDim.x, rawv, sm_b, sm_a); } }
        if (PREP_MASK & 2) { int hcur = -1; bool first_ = true; GlaRaw R; float wl[16], bias = 0.f;
            for (int it = blockIdx.x; it < 2048; it += gridDim.x) {
                if ((it & 3) != hcur) { hcur = it & 3; const float* wlr = P.in[9] + hcur * 128 + (threadIdx.x & 127);
#pragma unroll
                    for (int r = 0; r < 16; ++r) wl[r] = wlr[r * 512];
                    bias = P.in[10][hcur * 128 + (threadIdx.x & 127)]; }
                if (first_) { gla_load_raw(P, it, R); first_ = false; }
                prep_gla(P, lds, it, it + (int)gridDim.x, R, wl, bias); } }
}
__global__ void __launch_bounds__(512, 2) mega_fwd(Params P) {
    extern __shared__ __attribute__((aligned(16))) unsigned char shm[];
    LAS uchar* lds = (LAS uchar*)shm;
    cg::grid_group grid = cg::this_grid();
    uchar* ws = P.ws;
    const int lo = P.lo, hi = P.hi;
#ifndef PH_MASK
#define PH_MASK 0x3fff
#endif
#define IN(k) (((PH_MASK >> (k)) & 1) && lo <= (k) && (k) < hi)
#ifndef REP_MASK
#define REP_MASK 0
#endif
#define REP(k) ((REP_MASK >> (k)) & 1)
#define SEAM(k) do { if (IN(k) && IN((k) + 1)) grid.sync(); } while (0)
#ifndef DBG_Q
#define DBG_Q 10.0f
#endif
#ifdef DBG_T
    unsigned long long ta0 = __builtin_amdgcn_s_memrealtime(), ta1 = 0;
#endif
    if (IN(0)) { phase0<false, true>(P, lds); } SEAM(0);
#ifdef DBG_T
    if (DBG_T == 100) ta1 = __builtin_amdgcn_s_memrealtime();
#endif
    if (IN(1)) { phase_norm1<false>(P); phase0<true, false>(P, lds); } SEAM(1);
    if (IN(2)) { run_gemm<M_INPROJ>(lds, (const bf16*)(ws + WS_HB), (const bf16*)(ws + WS_WIN), WIN1_ROWS, 1024, ws, nullptr, nullptr); if (REP(2)) { grid.sync(); run_gemm<M_INPROJ>(lds, (const bf16*)(ws + WS_HB), (const bf16*)(ws + WS_WIN), WIN1_ROWS, 1024, ws, nullptr, nullptr); } } SEAM(2);
    unsigned long long tt0 = 0, tt1 = 0;
#ifdef DBG_T
    if (DBG_T == 3) tt0 = __builtin_amdgcn_s_memrealtime();
#endif
    if (IN(3)) { phase_prep(P, lds); if (REP(3)) { grid.sync(); run_gemm<M_INPROJ>(lds, (const bf16*)(ws + WS_HB), (const bf16*)(ws + WS_WIN), WIN1_ROWS, 1024, ws, nullptr, nullptr); grid.sync(); phase_prep(P, lds); }
    } SEAM(3);
#ifdef DBG_T
    if (DBG_T == 3) tt1 = __builtin_amdgcn_s_memrealtime();
    if (DBG_T == 4) tt0 = __builtin_amdgcn_s_memrealtime();
#endif
    if (IN(4)) { phase_scan(P, lds); if (REP(4)) { grid.sync(); phase_scan(P, lds); } } SEAM(4);
#ifdef DBG_T
    if (DBG_T == 4) tt1 = __builtin_amdgcn_s_memrealtime();
#endif
    if (IN(6)) { run_gemm<M_GATES>(lds, (const bf16*)(ws + WS_HB), (const bf16*)(ws + WS_WIN) + (size_t)WIN1_ROWS * 1024, WIN2_ROWS, 1024, ws, P.in[11], P.in[15], (uchar*)P.out); if (REP(6)) { grid.sync(); run_gemm<M_GATES>(lds, (const bf16*)(ws + WS_HB), (const bf16*)(ws + WS_WIN) + (size_t)WIN1_ROWS * 1024, WIN2_ROWS, 1024, ws, P.in[11], P.in[15], (uchar*)P.out); } } SEAM(6);
    if (IN(7)) { run_gemm<M_BRA>(lds, (const bf16*)P.out, (const bf16*)(ws + WS_WBG), 1024, 1024, ws, nullptr, nullptr); if (REP(7)) { grid.sync(); run_gemm<M_BRA>(lds, (const bf16*)P.out, (const bf16*)(ws + WS_WBG), 1024, 1024, ws, nullptr, nullptr); } }   __syncthreads();
    if (IN(8)) { run_gemm<M_BRD>(lds, (const bf16*)(ws + WS_DV), (const bf16*)(ws + DBG_BRD_B), 1024, 1024, ws, nullptr, nullptr); if (REP(8)) { grid.sync(); run_gemm<M_BRD>(lds, (const bf16*)(ws + WS_DV), (const bf16*)(ws + DBG_BRD_B), 1024, 1024, ws, nullptr, nullptr); } } SEAM(8);
    if (IN(9)) { run_gemm<M_OUT>(lds, (const bf16*)(ws + WS_MG), (const bf16*)(ws + WS_WOUT), 1024, 1024, ws, nullptr, nullptr); if (REP(9)) { grid.sync(); run_gemm<M_OUT>(lds, (const bf16*)(ws + WS_MG), (const bf16*)(ws + WS_WOUT), 1024, 1024, ws, nullptr, nullptr); } } SEAM(9);
    if (IN(10)) { phase_row1(P); if (REP(10)) { grid.sync(); phase_row1(P); } } SEAM(10);
    if (IN(11)) { run_gemm<M_MLP1>(lds, (const bf16*)(ws + WS_H2), (const bf16*)(ws + WS_W1), 4096, 1024, ws, nullptr, nullptr); if (REP(11)) { grid.sync(); run_gemm<M_MLP1>(lds, (const bf16*)(ws + WS_H2), (const bf16*)(ws + WS_W1), 4096, 1024, ws, nullptr, nullptr); } } SEAM(11);
    if (IN(12)) { run_gemm<M_MLP2>(lds, (const bf16*)(ws + WS_A1), (const bf16*)(ws + WS_W2), 1024, 4096, ws, nullptr, nullptr); if (REP(12)) { grid.sync(); run_gemm<M_MLP2>(lds, (const bf16*)(ws + WS_A1), (const bf16*)(ws + WS_W2), 1024, 4096, ws, nullptr, nullptr); } } SEAM(12);
    if (IN(13)) { phase_row2(P); }
#ifdef DBG_T
    if (DBG_T == 0) { tt1 = __builtin_amdgcn_s_memrealtime(); }
    if (DBG_T == 100) { tt0 = ta0; tt1 = ta1; }
    if (DBG_T == 200) { grid.sync(); tt0 = __builtin_amdgcn_s_memrealtime(); for (int q_ = 0; q_ < 16; ++q_) grid.sync(); tt1 = __builtin_amdgcn_s_memrealtime(); }
    grid.sync(); for (size_t i = (size_t)blockIdx.x * 512 + threadIdx.x; i < (size_t)T * 1024; i += (size_t)gridDim.x * 512) P.out[i] = P.in[0][i];
    grid.sync(); if (blockIdx.x == DBG_TB && threadIdx.x == 0) P.out[0] += floorf((float)(tt1 - tt0) * 0.01f / DBG_Q + 0.5f) * DBG_Q;
#endif
#undef IN
#undef SEAM
}

#ifdef DBG_STOP
__global__ void __launch_bounds__(256) dbg_dump(const bf16* src, float* out) {
    for (size_t i = (size_t)blockIdx.x * 256 + threadIdx.x; i < (size_t)T * 1024; i += (size_t)gridDim.x * 256) { unsigned hsh = ((unsigned)src[i] + 1u) * 2654435761u; hsh ^= hsh >> 15; hsh *= 2246822519u; out[i] = (float)(hsh >> 8) * (1.0f / 16777216.0f); }
}
#endif
#ifndef N_LAUNCH_MODE
#define N_LAUNCH_MODE 1
#endif
extern "C" void kernel_launch(void* const* d_in, const int* in_sizes, int n_in, void* d_out, int out_size, void* d_ws, size_t ws_size, hipStream_t stream) {
    static int grid_blocks = 0;
    if (!grid_blocks) {
        int dev = 0, cus = 0, per_cu = 0;
        hipGetDevice(&dev);
        hipDeviceGetAttribute(&cus, hipDeviceAttributeMultiprocessorCount, dev);
        hipFuncSetAttribute((const void*)mega_fwd, hipFuncAttributeMaxDynamicSharedMemorySize, LDS_BYTES);
        hipOccupancyMaxActiveBlocksPerMultiprocessor(&per_cu, (const void*)mega_fwd, 512, LDS_BYTES);
        if (per_cu < 1) { fprintf(stderr, "kernel_launch: occupancy query gives %d blocks per CU\n", per_cu); per_cu = 1; }
        grid_blocks = cus * per_cu;
        if (grid_blocks > 256) grid_blocks = 256;
        if (n_in != 21 || ws_size < WS_END) fprintf(stderr, "kernel_launch: unexpected n_in %d or ws_size %zu (< %zu)\n", n_in, ws_size, (size_t)WS_END);
    }
    Params p{};
    for (int i = 0; i < 21; ++i) p.in[i] = (const float*)d_in[i];
    p.out = (float*)d_out; p.ws = (uchar*)d_ws;
    if (N_LAUNCH_MODE == 1) {
        p.lo = 0; p.hi = NPHASE;
        void* args[] = {&p};
        hipError_t e = hipLaunchCooperativeKernel((const void*)mega_fwd, dim3(grid_blocks), dim3(512), args, LDS_BYTES, stream);
        if (e != hipSuccess) fprintf(stderr, "cooperative launch failed: %s (grid %d)\n", hipGetErrorString(e), grid_blocks);
    } else {
#ifdef DBG_STOP
        for (int k = 0; k <= DBG_STOP; ++k) { p.lo = k; p.hi = k + 1; hipLaunchKernelGGL(mega_fwd, dim3(grid_blocks), dim3(512), LDS_BYTES, stream, p); }
        hipLaunchKernelGGL(dbg_dump, dim3(2048), dim3(256), 0, stream, (const bf16*)((uchar*)d_ws + (size_t)DBG_SRC * MiB), (float*)d_out);
#else
        for (int k = 0; k < NPHASE; ++k) { p.lo = k; p.hi = k + 1; hipLaunchKernelGGL(mega_fwd, dim3(grid_blocks), dim3(512), LDS_BYTES, stream, p); }
#endif
    }
}
```

```cpp
#include <hip/hip_runtime.h>
#include <hip/hip_cooperative_groups.h>
#include <cstdio>
#include <cstdint>
namespace cg = cooperative_groups;
namespace pg8 {
#define PG8_LAS __attribute__((address_space(3)))
typedef unsigned short bf16_t;
typedef short bf16x8 __attribute__((ext_vector_type(8)));
typedef float f32x4 __attribute__((ext_vector_type(4)));
typedef unsigned u32x4 __attribute__((ext_vector_type(4)));
constexpr int BM = 256, BK = 64, HALF = 128, HTB = HALF * BK * 2  , STAGE_BYTES = 8 * HTB, NXCD = 8, WGM = 8;

__host__ __device__ __forceinline__ int lds_byte(int r, int c) { const int st = (r >> 4) * 2 + (c >> 5), rr = r & 15, cc = c & 31, ob = rr * 64 + cc * 2; return st * 1024 + (ob ^ (((ob >> 9) & 1) << 5)); }
__host__ __device__ __forceinline__ void stage_rc(int b, int& R, int& C) { const int st = b / 1024, sb = b % 1024, swz = sb ^ (((sb >> 9) & 1) << 5); R = (st >> 1) * 16 + swz / 64; C = (st & 1) * 32 + (swz % 64) / 2; }
__host__ __device__ __forceinline__ int perm32(int rho) { const int n = rho >> 4, i = rho & 15; return 8 * (i >> 2) + 4 * n + (i & 3); }

struct Unit { int pm, pn; };
struct Gemm { const bf16_t* A; const bf16_t* Bt; int M, N, K; };

struct StaticOrder {
    int nM, nN, nwg, G, c;
    __host__ __device__ void init(int M, int N, int G_, int c_) { nM = M / BM; nN = N / BM; nwg = nM * nN; G = G_; c = c_; }
    __host__ __device__ bool next(int i, Unit& u) const {
        const long L = (long)i * G + c; if (L >= nwg) return false;
        int wgid = (int)L; { const int q = nwg / NXCD, r = nwg % NXCD, xcd = wgid % NXCD, off = wgid / NXCD; wgid = (xcd < r ? xcd * (q + 1) : r * (q + 1) + (xcd - r) * q) + off; }
        const int nig = WGM * nN, gid = wgid / nig, fm = gid * WGM, gsz = (nM - fm) < WGM ? (nM - fm) : WGM;
        u.pm = fm + ((wgid % nig) % gsz); u.pn = (wgid % nig) / gsz; return true;
    }
    __device__ __forceinline__ void a_ready(const Unit&) const {}
    __device__ __forceinline__ void done(const Unit&) const {}
};
__device__ __forceinline__ unsigned cvt_pk_bf16(float lo, float hi) { unsigned r; asm volatile("v_cvt_pk_bf16_f32 %0, %1, %2" : "=v"(r) : "v"(lo), "v"(hi)); return r; }
template <class Epi, class Sched, bool ALIGN_EPI = false, bool SP2 = false>
__device__ __forceinline__ void gemm_phase(PG8_LAS unsigned char* lds, const Gemm g, const Sched& S, const Epi& E) {
    const int tid = threadIdx.x, wid = __builtin_amdgcn_readfirstlane(tid >> 6), lane = tid & 63, wr = wid >> 2, wc = wid & 3, fr = lane & 15, fq = lane >> 4;
    const int K = g.K, nt = K / BK;
    unsigned voffA[2], voffB[2];
#pragma unroll
    for (int i = 0; i < 2; ++i) { int R, C; stage_rc(tid * 16 + i * 8192, R, C); const int Rb = Epi::PERM ? ((R & ~31) + perm32(R & 31)) : R;
        voffA[i] = (unsigned)(R * K + C) * 2u; voffB[i] = (unsigned)(Rb * K + C) * 2u; }
    const size_t kstep = (size_t)(BK * 2);
    const size_t hstep = (size_t)HALF * K * 2;
    const size_t tstep = 2 * hstep;
    const unsigned ldsw = (unsigned)wid * 1024u;
    const int aoff = lds_byte(wr * 64 + fr, fq * 8), boff = lds_byte(wc * 32 + fr, fq * 8);
#define PG8_SA(b, h) (((b) * 2 + (h)) * HTB)
#define PG8_SB(b, h) ((4 + (b) * 2 + (h)) * HTB)
#define PG8_STAGE(bufoff, gbase, voff) do { _Pragma("unroll") for (int _i = 0; _i < 2; ++_i) \
        __builtin_amdgcn_global_load_lds((const unsigned*)((const char*)(gbase) + (voff)[_i]), (PG8_LAS unsigned*)(lds + (bufoff) + ldsw + _i * 8192), 16, 0, 0); } while (0)
#define PG8_LDA(dst, b, h) do { _Pragma("unroll") for (int m = 0; m < 4; ++m) _Pragma("unroll") for (int k = 0; k < 2; ++k) dst[m][k] = *(const PG8_LAS bf16x8*)(lds + PG8_SA(b, h) + aoff + m * 2048 + k * 1024); } while (0)
#define PG8_LDB(dst, b, h) do { _Pragma("unroll") for (int n = 0; n < 2; ++n) _Pragma("unroll") for (int k = 0; k < 2; ++k) dst[n][k] = *(const PG8_LAS bf16x8*)(lds + PG8_SB(b, h) + boff + n * 2048 + k * 1024); } while (0)
#define PG8_MMA(ai, bj, At, Bt) do { __builtin_amdgcn_s_setprio(1); _Pragma("unroll") for (int m = 0; m < 4; ++m) _Pragma("unroll") for (int n = 0; n < 2; ++n) _Pragma("unroll") for (int k = 0; k < 2; ++k) \
        acc[ai][bj][m][n] = __builtin_amdgcn_mfma_f32_16x16x32_bf16(Bt[n][k], At[m][k], acc[ai][bj][m][n], 0, 0, 0); __builtin_amdgcn_s_setprio(0); } while (0)
#define PG8_WAIT_V(n) asm volatile("s_waitcnt vmcnt(" #n ")" ::: "memory")
#define PG8_WAIT_L(n) asm volatile("s_waitcnt lgkmcnt(" #n ")" ::: "memory")
#define PG8_BAR __builtin_amdgcn_s_barrier()
#define PG8_SCHED __builtin_amdgcn_sched_barrier(0)
    Unit cur, nxt; int ui = 0;
    if (!S.next(0, cur)) return;
    f32x4 acc[2][2][4][2];
#pragma unroll
    for (int a = 0; a < 2; ++a)
#pragma unroll
        for (int b = 0; b < 2; ++b)
#pragma unroll
            for (int m = 0; m < 4; ++m)
#pragma unroll
                for (int n = 0; n < 2; ++n) acc[a][b][m][n] = (f32x4){0.f, 0.f, 0.f, 0.f};
    bf16x8 At[4][2], B0[2][2], B1[2][2];
    const char* cA = (const char*)g.A + (size_t)cur.pm * tstep; const char* cB = (const char*)g.Bt + (size_t)cur.pn * tstep;
    S.a_ready(cur);
    if constexpr (SP2) {
        PG8_STAGE(PG8_SB(0, 0), cB, voffB); PG8_STAGE(PG8_SB(0, 1), cB + hstep, voffB); PG8_STAGE(PG8_SA(0, 0), cA, voffA); PG8_STAGE(PG8_SA(0, 1), cA + hstep, voffA);
        if (wr == 1) PG8_BAR;
        PG8_WAIT_V(2); PG8_BAR;
        PG8_STAGE(PG8_SB(1, 0), cB + kstep, voffB); PG8_STAGE(PG8_SA(1, 0), cA + kstep, voffA); PG8_STAGE(PG8_SB(1, 1), cB + hstep + kstep, voffB);
        PG8_WAIT_V(6); PG8_BAR;
    } else {
        PG8_STAGE(PG8_SB(0, 0), cB, voffB); PG8_STAGE(PG8_SA(0, 0), cA, voffA); PG8_STAGE(PG8_SB(0, 1), cB + hstep, voffB); PG8_STAGE(PG8_SA(0, 1), cA + hstep, voffA);
        if (wr == 1) PG8_BAR;
        PG8_WAIT_V(4); PG8_BAR;
        PG8_STAGE(PG8_SB(1, 0), cB + kstep, voffB); PG8_STAGE(PG8_SA(1, 0), cA + kstep, voffA); PG8_STAGE(PG8_SB(1, 1), cB + hstep + kstep, voffB);
        PG8_WAIT_V(6); PG8_BAR;
    }
    for (;;) {
        const bool has_next = S.next(ui + 1, nxt);
        const char* nA = has_next ? (const char*)g.A + (size_t)nxt.pm * tstep : cA; const char* nB = has_next ? (const char*)g.Bt + (size_t)nxt.pn * tstep : cB;
        for (int t = 0; t < nt; t += 2) {
            const bool last = (t == nt - 2);
            const char* a1 = cA + (size_t)(t + 1) * kstep;
            const char* a2 = last ? nA : cA + (size_t)(t + 2) * kstep; const char* b2 = last ? nB : cB + (size_t)(t + 2) * kstep;
            const char* a3 = a2 + kstep; const char* b3 = b2 + kstep;
            if (last && has_next) S.a_ready(nxt);
            if constexpr (SP2) {
            PG8_LDB(B0, 0, 0); PG8_LDB(B1, 0, 1); PG8_SCHED; PG8_LDA(At, 0, 0); PG8_STAGE(PG8_SA(1, 1), a1 + hstep, voffA);
            PG8_WAIT_V(8); PG8_WAIT_L(0); PG8_BAR; PG8_MMA(0, 0, At, B0); PG8_MMA(0, 1, At, B1); PG8_BAR; PG8_SCHED;
            PG8_LDA(At, 0, 1); PG8_STAGE(PG8_SB(0, 0), b2, voffB); PG8_STAGE(PG8_SB(0, 1), b2 + hstep, voffB); PG8_STAGE(PG8_SA(0, 0), a2, voffA);
            PG8_WAIT_V(8); PG8_WAIT_L(0); PG8_BAR; PG8_MMA(1, 0, At, B0); PG8_MMA(1, 1, At, B1); PG8_BAR; PG8_SCHED;
            PG8_LDB(B0, 1, 0); PG8_LDB(B1, 1, 1); PG8_SCHED; PG8_LDA(At, 1, 0); PG8_STAGE(PG8_SA(0, 1), a2 + hstep, voffA);
            PG8_WAIT_V(8); PG8_WAIT_L(0); PG8_BAR; PG8_MMA(0, 0, At, B0); PG8_MMA(0, 1, At, B1); PG8_BAR; PG8_SCHED;
            PG8_LDA(At, 1, 1); PG8_STAGE(PG8_SB(1, 0), b3, voffB); PG8_STAGE(PG8_SB(1, 1), b3 + hstep, voffB); PG8_STAGE(PG8_SA(1, 0), a3, voffA);
            PG8_WAIT_V(8); PG8_WAIT_L(0); PG8_BAR; PG8_MMA(1, 0, At, B0); PG8_MMA(1, 1, At, B1); PG8_BAR; PG8_SCHED;
            } else {
            PG8_LDB(B0, 0, 0); PG8_SCHED; PG8_LDA(At, 0, 0); PG8_STAGE(PG8_SA(1, 1), a1 + hstep, voffA);
            PG8_WAIT_L(8); PG8_BAR; PG8_WAIT_L(0); PG8_MMA(0, 0, At, B0); PG8_BAR; PG8_SCHED;
            PG8_LDB(B1, 0, 1); PG8_STAGE(PG8_SB(0, 0), b2, voffB);
            PG8_BAR; PG8_WAIT_L(0); PG8_MMA(0, 1, At, B1); PG8_BAR;
            PG8_LDA(At, 0, 1); PG8_STAGE(PG8_SA(0, 0), a2, voffA);
            PG8_BAR; PG8_WAIT_L(0); PG8_MMA(1, 0, At, B0); PG8_BAR; PG8_SCHED;
            PG8_STAGE(PG8_SB(0, 1), b2 + hstep, voffB);
            PG8_WAIT_V(6); PG8_BAR; PG8_MMA(1, 1, At, B1); PG8_BAR;
            PG8_LDB(B0, 1, 0); PG8_SCHED; PG8_LDA(At, 1, 0); PG8_STAGE(PG8_SA(0, 1), a2 + hstep, voffA);
            PG8_WAIT_L(8); PG8_BAR; PG8_WAIT_L(0); PG8_MMA(0, 0, At, B0); PG8_BAR; PG8_SCHED;
            PG8_LDB(B1, 1, 1); PG8_STAGE(PG8_SB(1, 0), b3, voffB);
            PG8_BAR; PG8_WAIT_L(0); PG8_MMA(0, 1, At, B1); PG8_BAR;
            PG8_LDA(At, 1, 1); PG8_STAGE(PG8_SA(1, 0), a3, voffA);
            PG8_BAR; PG8_WAIT_L(0); PG8_MMA(1, 0, At, B0); PG8_BAR; PG8_SCHED;
            PG8_STAGE(PG8_SB(1, 1), b3 + hstep, voffB);
            PG8_WAIT_V(6); PG8_BAR; PG8_MMA(1, 1, At, B1); PG8_BAR;
            }
        }
        if constexpr (ALIGN_EPI) { if (wr == 0) PG8_BAR; }
        if constexpr (!Epi::AFTER_DRAIN) { E(acc, cur, wr, wc, fr, fq); S.done(cur); }
        if (!has_next) break;
#pragma unroll
        for (int a = 0; a < 2; ++a)
#pragma unroll
            for (int b = 0; b < 2; ++b)
#pragma unroll
                for (int m = 0; m < 4; ++m)
#pragma unroll
                    for (int n = 0; n < 2; ++n) acc[a][b][m][n] = (f32x4){0.f, 0.f, 0.f, 0.f};
        cur = nxt; cA = nA; cB = nB; ++ui;
        if constexpr (ALIGN_EPI) { if (wr == 1) PG8_BAR; }
    }
    PG8_WAIT_V(0);
    if constexpr (!ALIGN_EPI) { if (wr == 0) PG8_BAR; }
    PG8_BAR;
    if constexpr (Epi::AFTER_DRAIN) { E.fused(acc, cur, wr, wc, fr, fq, lds, wid, lane); S.done(cur); }
#undef PG8_SA
#undef PG8_SB
#undef PG8_STAGE
#undef PG8_LDA
#undef PG8_LDB
#undef PG8_MMA
#undef PG8_WAIT_V
#undef PG8_WAIT_L
#undef PG8_BAR
#undef PG8_SCHED
}
}

#define LAS __attribute__((address_space(3)))
typedef unsigned short bf16;
typedef unsigned char uchar;
typedef unsigned v4u __attribute__((ext_vector_type(4)));
typedef unsigned v2u __attribute__((ext_vector_type(2)));
typedef float f32x4 __attribute__((ext_vector_type(4)));
typedef short bf16x8 __attribute__((ext_vector_type(8)));
#define MFMA16(a, b, c) __builtin_amdgcn_mfma_f32_16x16x32_bf16((a), (b), (c), 0, 0, 0)

constexpr int T = 32768, DM = 1024, SEQ = 16384, NCHK = 256;
constexpr float EPS = 1e-6f;
constexpr size_t MiB = 1u << 20;
constexpr size_t WS_PROG = 65536;
constexpr size_t WS_MOD = 0, WS_SS = 1 * MiB, WS_DEC = 3 * MiB, WS_SM = 6 * MiB, WS_HALO = 10 * MiB;
constexpr size_t WS_WIN = 20 * MiB, WS_WBG = 39 * MiB, WS_WBD = 41 * MiB, WS_WOUT = 43 * MiB, WS_W1 = 45 * MiB, WS_W2 = 53 * MiB;
constexpr size_t WS_HB = 64 * MiB, WS_AQ = 128 * MiB, WS_AK = 160 * MiB, WS_AV = 192 * MiB, WS_DQ = 256 * MiB, WS_DK = 320 * MiB, WS_DV = 384 * MiB;
constexpr size_t WS_ATTD = 448 * MiB, WS_ATTA = 480 * MiB, WS_SSP = 496 * MiB, WS_END = 512 * MiB;
constexpr size_t WS_SGA = 128 * MiB, WS_SGD = 256 * MiB, WS_YA = 320 * MiB, WS_MG = 128 * MiB, WS_Z = 256 * MiB, WS_H2 = 64 * MiB, WS_A1 = 128 * MiB, WS_Y = 384 * MiB;
constexpr int WIN1_ROWS = 5376, WIN2_ROWS = 4096;
constexpr int LDS_BYTES = 163840;
constexpr int NPHASE = 14;

struct Params { const float* in[21]; float* out; uchar* ws; int lo, hi; };

typedef float f32x2_ __attribute__((ext_vector_type(2)));
typedef __bf16 bf16x2_ __attribute__((ext_vector_type(2)));
__device__ __forceinline__ unsigned f2bf(float f) { unsigned u = __float_as_uint(f); return (u + 0x7fffu + ((u >> 16) & 1u)) >> 16; }
__device__ __forceinline__ unsigned pk2(float lo, float hi) { const f32x2_ v = {lo, hi}; return __builtin_bit_cast(unsigned, __builtin_convertvector(v, bf16x2_)); }
__device__ __forceinline__ float bf2f(unsigned b) { return __uint_as_float(b << 16); }
__device__ __forceinline__ float bflo(unsigned w) { return __uint_as_float(w << 16); }
__device__ __forceinline__ float bfhi(unsigned w) { return __uint_as_float(w & 0xffff0000u); }
__device__ __forceinline__ bf16x8 pack8(f32x4 a, f32x4 b) { v4u p; p.x = pk2(a[0], a[1]); p.y = pk2(a[2], a[3]); p.z = pk2(b[0], b[1]); p.w = pk2(b[2], b[3]); return __builtin_bit_cast(bf16x8, p); }
typedef unsigned u32x2_ __attribute__((ext_vector_type(2)));
template <int CTRL> __device__ __forceinline__ float dpp_mov(float v) { return __uint_as_float(__builtin_amdgcn_update_dpp(0u, __float_as_uint(v), CTRL, 0xf, 0xf, true)); }
__device__ __forceinline__ float row16_sum(float v) { v += dpp_mov<0xB1>(v); v += dpp_mov<0x4E>(v); v += dpp_mov<0x141>(v); v += dpp_mov<0x140>(v); return v; }
__device__ __forceinline__ float xsum16(float x) { const unsigned u = __float_as_uint(x); const u32x2_ r = __builtin_amdgcn_permlane16_swap(u, u, false, false); return __uint_as_float(r.x) + __uint_as_float(r.y); }
__device__ __forceinline__ float xsum32(float x) { const unsigned u = __float_as_uint(x); const u32x2_ r = __builtin_amdgcn_permlane32_swap(u, u, false, false); return __uint_as_float(r.x) + __uint_as_float(r.y); }
__device__ __forceinline__ float wave_sum(float v) { return xsum32(xsum16(row16_sum(v))); }
__device__ __forceinline__ float sigmoidf_(float x) { return __builtin_amdgcn_rcpf(1.0f + __expf(-x)); }
__device__ __forceinline__ float siluf_(float x) { return x * __builtin_amdgcn_rcpf(1.0f + __expf(-x)); }
__device__ __forceinline__ float softplusf_(float x) { return fmaxf(x, 0.f) + __logf(1.0f + __expf(-fabsf(x))); }

__device__ __forceinline__ int win_dest_row(int j) {
    if (j < 2048) return j;
    if (j < 3072) return WIN1_ROWS + (j - 2048);
    if (j < 3088) return 5120 + (j - 3072);
    if (j < 6160) return 2048 + (j - 3088);
    if (j < 7184) return WIN1_ROWS + 1024 + (j - 6160);
    if (j < 7200) return 5136 + (j - 7184);
    return WIN1_ROWS + 2048 + (j - 7200);
}
template <bool REMAP>
__device__ __forceinline__ void tr_item(const float* W, int K, int N, bf16* WT, LAS float* scr, int item, int lane) {
    const int nblk = N / 32, kb = item / nblk, nb = item % nblk, k0 = 64 * kb, n0 = 32 * nb;
#pragma unroll 16
    for (int i = 0; i < 32; ++i) { const int kk = 2 * i + (lane >> 5); scr[kk * 33 + (lane & 31)] = W[(size_t)(k0 + kk) * N + n0 + (lane & 31)]; }
    asm volatile("s_waitcnt lgkmcnt(0)" ::: "memory");
    const int c = lane & 7;
#pragma unroll
    for (int j = 0; j < 4; ++j) { const int n = (lane >> 3) + 8 * j; const LAS float* s = scr + (8 * c) * 33 + n;
        v4u o; o.x = pk2(s[0 * 33], s[1 * 33]); o.y = pk2(s[2 * 33], s[3 * 33]); o.z = pk2(s[4 * 33], s[5 * 33]); o.w = pk2(s[6 * 33], s[7 * 33]);
        const int dr = REMAP ? win_dest_row(n0 + n) : (n0 + n);
        *(v4u*)(WT + (size_t)dr * K + k0 + 8 * c) = o; }
    asm volatile("s_waitcnt lgkmcnt(0)" ::: "memory");
}
template <bool DO_W, bool DO_MOD>
__device__ __forceinline__ void phase0(const Params& P, LAS uchar* lds) {
    const int tid = threadIdx.x, lane = tid & 63, wave = tid >> 6;
    const int gw = blockIdx.x * 8 + wave, NGW = gridDim.x * 8;
    LAS float* scr = (LAS float*)(lds + wave * 16384);
    uchar* ws = P.ws;
    constexpr int I_IN = 16 * 289, I_SQ = 16 * 32, I_1 = 16 * 128, I_2 = 64 * 32;
    constexpr int NITEMS = I_IN + 3 * I_SQ + I_1 + I_2;
    if constexpr (DO_W)
    for (int it = gw; it < NITEMS; it += NGW) {
        int r = it;
        if (r < I_IN) { tr_item<true>(P.in[8], 1024, 9248, (bf16*)(ws + WS_WIN), scr, r, lane); continue; } r -= I_IN;
        if (r < I_SQ) { tr_item<false>(P.in[16], 1024, 1024, (bf16*)(ws + WS_WBG), scr, r, lane); continue; } r -= I_SQ;
        if (r < I_SQ) { tr_item<false>(P.in[17], 1024, 1024, (bf16*)(ws + WS_WBD), scr, r, lane); continue; } r -= I_SQ;
        if (r < I_SQ) { tr_item<false>(P.in[18], 1024, 1024, (bf16*)(ws + WS_WOUT), scr, r, lane); continue; } r -= I_SQ;
        if (r < I_1) { tr_item<false>(P.in[19], 1024, 4096, (bf16*)(ws + WS_W1), scr, r, lane); continue; } r -= I_1;
        tr_item<false>(P.in[20], 4096, 1024, (bf16*)(ws + WS_W2), scr, r, lane);
    }
    if (blockIdx.x == 0 && tid < 64) ((unsigned*)(ws + WS_PROG))[tid * 64] = 0u;
    { v4u* z = (v4u*)(ws + WS_WIN + (size_t)5152 * 2048); const int n16 = 224 * 128; const v4u zz = {0u, 0u, 0u, 0u};
      for (int i = blockIdx.x * 512 + tid; i < n16; i += gridDim.x * 512) z[i] = zz; }
    float* mod = (float*)(ws + WS_MOD);
    const float* cvec = P.in[1]; const float* aw = P.in[2]; const float* ab = P.in[3];
    if constexpr (DO_MOD)
    for (int task = gw; task < 384; task += NGW) {
        const int cq = lane & 3, rg = lane >> 2, col = task * 16 + cq * 4;
        f32x4 a0 = {0.f, 0.f, 0.f, 0.f}, a1 = {0.f, 0.f, 0.f, 0.f};
#pragma unroll 8
        for (int i = 0; i < 64; ++i) { const int k = rg + 16 * i;
            const float s0 = siluf_(cvec[k]), s1 = siluf_(cvec[1024 + k]);
            const f32x4 w = *(const f32x4*)(aw + (size_t)k * 6144 + col);
            a0 += w * s0; a1 += w * s1; }
#pragma unroll
        for (int e = 0; e < 4; ++e) {
#pragma unroll
            for (int o = 4; o < 64; o <<= 1) { a0[e] += __shfl_xor(a0[e], o); a1[e] += __shfl_xor(a1[e], o); } }
        if (rg == 0) { const f32x4 bb = *(const f32x4*)(ab + col); *(f32x4*)(mod + col) = a0 + bb; *(f32x4*)(mod + 6144 + col) = a1 + bb; }
    }
}

template <bool WITH_SS>
__device__ __forceinline__ void phase_norm1(const Params& P) {
    const int tid = threadIdx.x, lane = tid & 63, wave = tid >> 6;
    const int gw = blockIdx.x * 8 + wave, NGW = gridDim.x * 8;
    const float* x = P.in[0]; const float* w = P.in[4]; const float* mod = (const float*)(P.ws + WS_MOD);
    bf16* hb = (bf16*)(P.ws + WS_HB);
    f32x4 vnx[4]; v2u qan[4], qdn[4];
    if (gw < T) {
#pragma unroll
        for (int j = 0; j < 4; ++j) { vnx[j] = ((const f32x4*)(x + (size_t)gw * DM) + lane)[64 * j];
            if constexpr (WITH_SS) { qan[j] = ((const v2u*)((const bf16*)P.out + (size_t)gw * DM) + lane)[64 * j]; qdn[j] = ((const v2u*)((const bf16*)((const uchar*)P.out + 64 * MiB) + (size_t)gw * DM) + lane)[64 * j]; } }
    }
    for (int m = gw; m < T; m += NGW) {
        const int b = m / SEQ; const float* mb = mod + b * 6144;
        f32x4 v[4]; v2u qac[4], qdc[4]; float s = 0.f;
#pragma unroll
        for (int j = 0; j < 4; ++j) { v[j] = vnx[j]; if constexpr (WITH_SS) { qac[j] = qan[j]; qdc[j] = qdn[j]; } }
        if (m + NGW < T) {
            const int mn = m + NGW;
#pragma unroll
            for (int j = 0; j < 4; ++j) { vnx[j] = ((const f32x4*)(x + (size_t)mn * DM) + lane)[64 * j];
                if constexpr (WITH_SS) { qan[j] = ((const v2u*)((const bf16*)P.out + (size_t)mn * DM) + lane)[64 * j]; qdn[j] = ((const v2u*)((const bf16*)((const uchar*)P.out + 64 * MiB) + (size_t)mn * DM) + lane)[64 * j]; } }
        }
#pragma unroll
        for (int j = 0; j < 4; ++j) s += (v[j][0] * v[j][0] + v[j][1] * v[j][1]) + (v[j][2] * v[j][2] + v[j][3] * v[j][3]);
        const float r = rsqrtf(wave_sum(s) * (1.f / DM) + EPS);
        v2u* o = (v2u*)(hb + (size_t)m * DM) + lane;
#pragma unroll
        for (int j = 0; j < 4; ++j) { const int col = 4 * (lane + 64 * j);
            const f32x4 ww = *(const f32x4*)(w + col), sc = *(const f32x4*)(mb + 1024 + col), sh = *(const f32x4*)(mb + col);
            const f32x4 y = v[j] * r * ww * (sc + 1.0f) + sh;
            v2u q; q.x = pk2(y[0], y[1]); q.y = pk2(y[2], y[3]); o[64 * j] = q; }
        if constexpr (WITH_SS) {
            float* ss = (float*)(P.ws + WS_SS) + (size_t)m * 16;
#pragma unroll
            for (int j = 0; j < 4; ++j) {
                const v2u qa = qac[j], qd = qdc[j];
                const float a0 = bflo(qa.x), a1 = bfhi(qa.x), a2 = bflo(qa.y), a3 = bfhi(qa.y);
                const float d0 = bflo(qd.x), d1 = bfhi(qd.x), d2 = bflo(qd.y), d3 = bfhi(qd.y);
                float sa = (a0 * a0 + a1 * a1) + (a2 * a2 + a3 * a3), sd = (d0 * d0 + d1 * d1) + (d2 * d2 + d3 * d3);
                sa = wave_sum(sa); sd = xsum16(row16_sum(sd));
                if (lane == 0) ss[8 + j] = sa;
                if ((lane & 31) == 0) ss[2 * j + (lane >> 5)] = sd;
            }
        }
    }
}
__device__ __forceinline__ void phase_ss(const Params& P) {
    const int tid = threadIdx.x, lane = tid & 63, wave = tid >> 6;
    const int gw = blockIdx.x * 8 + wave, NGW = gridDim.x * 8;
    const bf16* oab = (const bf16*)P.out; const bf16* odb = (const bf16*)(P.ws + WS_DV);
    v2u qan[4], qdn[4];
    if (gw < T) {
#pragma unroll
        for (int j = 0; j < 4; ++j) { qan[j] = ((const v2u*)(oab + (size_t)gw * DM) + lane)[64 * j]; qdn[j] = ((const v2u*)(odb + (size_t)gw * DM) + lane)[64 * j]; }
    }
    for (int m = gw; m < T; m += NGW) {
        v2u qac[4], qdc[4];
#pragma unroll
        for (int j = 0; j < 4; ++j) { qac[j] = qan[j]; qdc[j] = qdn[j]; }
        if (m + NGW < T) { const int mn = m + NGW;
#pragma unroll
            for (int j = 0; j < 4; ++j) { qan[j] = ((const v2u*)(oab + (size_t)mn * DM) + lane)[64 * j]; qdn[j] = ((const v2u*)(odb + (size_t)mn * DM) + lane)[64 * j]; } }
        float* ss = (float*)(P.ws + WS_SS) + (size_t)m * 16;
#pragma unroll
        for (int j = 0; j < 4; ++j) {
            const v2u qa = qac[j], qd = qdc[j];
            const float a0 = bflo(qa.x), a1 = bfhi(qa.x), a2 = bflo(qa.y), a3 = bfhi(qa.y);
            const float d0 = bflo(qd.x), d1 = bfhi(qd.x), d2 = bflo(qd.y), d3 = bfhi(qd.y);
            float sa = (a0 * a0 + a1 * a1) + (a2 * a2 + a3 * a3), sd = (d0 * d0 + d1 * d1) + (d2 * d2 + d3 * d3);
            sa = wave_sum(sa); sd = xsum16(row16_sum(sd));
            if (lane == 0) ss[8 + j] = sa;
            if ((lane & 31) == 0) ss[2 * j + (lane >> 5)] = sd;
        }
    }
}
__device__ __forceinline__ void phase_row1(const Params& P) {
    const int tid = threadIdx.x, lane = tid & 63, wave = tid >> 6;
    const int gw = blockIdx.x * 8 + wave, NGW = gridDim.x * 8;
    const float* x = P.in[0]; const float* wpost = P.in[5]; const float* wpre = P.in[6]; const float* mod = (const float*)(P.ws + WS_MOD);
    const bf16* zb = (const bf16*)(P.ws + WS_Z); bf16* h2 = (bf16*)(P.ws + WS_H2);
    f32x4 vnx[4]; v2u znx[4];
    if (gw < T) {
#pragma unroll
        for (int j = 0; j < 4; ++j) { vnx[j] = ((const f32x4*)(x + (size_t)gw * DM) + lane)[64 * j]; znx[j] = ((const v2u*)(zb + (size_t)gw * DM) + lane)[64 * j]; }
    }
    for (int m = gw; m < T; m += NGW) {
        const int b = m / SEQ; const float* mb = mod + b * 6144;
        f32x4 v[4], z[4]; v2u zc[4]; float s = 0.f;
#pragma unroll
        for (int j = 0; j < 4; ++j) { v[j] = vnx[j]; zc[j] = znx[j]; }
        if (m + NGW < T) { const int mn = m + NGW;
#pragma unroll
            for (int j = 0; j < 4; ++j) { vnx[j] = ((const f32x4*)(x + (size_t)mn * DM) + lane)[64 * j]; znx[j] = ((const v2u*)(zb + (size_t)mn * DM) + lane)[64 * j]; } }
#pragma unroll
        for (int j = 0; j < 4; ++j) { const v2u q = zc[j]; z[j] = (f32x4){bflo(q.x), bfhi(q.x), bflo(q.y), bfhi(q.y)};
            s += (z[j][0] * z[j][0] + z[j][1] * z[j][1]) + (z[j][2] * z[j][2] + z[j][3] * z[j][3]); }
        const float r1 = rsqrtf(wave_sum(s) * (1.f / DM) + EPS); float s2 = 0.f;
        f32x4* orow = (f32x4*)(P.out + (size_t)m * DM) + lane;
#pragma unroll
        for (int j = 0; j < 4; ++j) { const int col = 4 * (lane + 64 * j);
            const f32x4 ww = *(const f32x4*)(wpost + col), g1 = *(const f32x4*)(mb + 2048 + col);
            v[j] = v[j] + g1 * (z[j] * r1 * ww); orow[64 * j] = v[j];
            s2 += (v[j][0] * v[j][0] + v[j][1] * v[j][1]) + (v[j][2] * v[j][2] + v[j][3] * v[j][3]); }
        const float r2 = rsqrtf(wave_sum(s2) * (1.f / DM) + EPS);
        v2u* o = (v2u*)(h2 + (size_t)m * DM) + lane;
#pragma unroll
        for (int j = 0; j < 4; ++j) { const int col = 4 * (lane + 64 * j);
            const f32x4 ww = *(const f32x4*)(wpre + col), sc = *(const f32x4*)(mb + 4096 + col), sh = *(const f32x4*)(mb + 3072 + col);
            const f32x4 y = v[j] * r2 * ww * (sc + 1.0f) + sh;
            v2u q; q.x = pk2(y[0], y[1]); q.y = pk2(y[2], y[3]); o[64 * j] = q; }
    }
}
__device__ __forceinline__ void phase_row2(const Params& P) {
    const int tid = threadIdx.x, lane = tid & 63, wave = tid >> 6;
    const int gw = blockIdx.x * 8 + wave, NGW = gridDim.x * 8;
    const float* wpost = P.in[7]; const float* mod = (const float*)(P.ws + WS_MOD);
    const bf16* yb = (const bf16*)(P.ws + WS_Y);
    f32x4 vnx[4]; v2u znx[4];
    if (gw < T) {
#pragma unroll
        for (int j = 0; j < 4; ++j) { vnx[j] = ((const f32x4*)(P.out + (size_t)gw * DM) + lane)[64 * j]; znx[j] = ((const v2u*)(yb + (size_t)gw * DM) + lane)[64 * j]; }
    }
    for (int m = gw; m < T; m += NGW) {
        const int b = m / SEQ; const float* mb = mod + b * 6144;
        f32x4* orow = (f32x4*)(P.out + (size_t)m * DM) + lane;
        f32x4 v[4], z[4]; v2u zc[4]; float s = 0.f;
#pragma unroll
        for (int j = 0; j < 4; ++j) { v[j] = vnx[j]; zc[j] = znx[j]; }
        if (m + NGW < T) { const int mn = m + NGW;
#pragma unroll
            for (int j = 0; j < 4; ++j) { vnx[j] = ((const f32x4*)(P.out + (size_t)mn * DM) + lane)[64 * j]; znx[j] = ((const v2u*)(yb + (size_t)mn * DM) + lane)[64 * j]; } }
#pragma unroll
        for (int j = 0; j < 4; ++j) { const v2u q = zc[j]; z[j] = (f32x4){bflo(q.x), bfhi(q.x), bflo(q.y), bfhi(q.y)};
            s += (z[j][0] * z[j][0] + z[j][1] * z[j][1]) + (z[j][2] * z[j][2] + z[j][3] * z[j][3]); }
        const float r1 = rsqrtf(wave_sum(s) * (1.f / DM) + EPS);
#pragma unroll
        for (int j = 0; j < 4; ++j) { const int col = 4 * (lane + 64 * j);
            const f32x4 ww = *(const f32x4*)(wpost + col), g2 = *(const f32x4*)(mb + 5120 + col);
            orow[64 * j] = v[j] + g2 * (z[j] * r1 * ww); }
    }
}

__device__ __forceinline__ v4u pack8f(const float (&v)[8]) { v4u w; w.x = pk2(v[0], v[1]); w.y = pk2(v[2], v[3]); w.z = pk2(v[4], v[5]); w.w = pk2(v[6], v[7]); return w; }
__device__ __forceinline__ void unpack8(const v4u q, float (&o)[8]) { o[0] = bflo(q.x); o[1] = bfhi(q.x); o[2] = bflo(q.y); o[3] = bfhi(q.y); o[4] = bflo(q.z); o[5] = bfhi(q.z); o[6] = bflo(q.w); o[7] = bfhi(q.w); }
#ifndef DBG_BRD_EXPR
#define DBG_BRD_EXPR (mg[e] + g[e] * v[e])
#endif
#ifndef PG8_ALIGN
#define PG8_ALIGN true
#endif
#ifndef PG8_SP2
#define PG8_SP2 true
#endif
constexpr int EPI_SSX_OFF = 131072;
enum { M_INPROJ = 0, M_GATES = 1, M_BRA = 2, M_BRD = 3, M_OUT = 4, M_MLP1 = 5, M_MLP2 = 6 };
template <int MODE> struct Epi {
    static constexpr bool PERM = true, AFTER_DRAIN = false;
    uchar* ws; const float* p0; const float* p1; uchar* ob; LAS uchar* ldsb;
    __device__ __forceinline__ void operator()(const pg8::f32x4 (&acc)[2][2][4][2], const pg8::Unit& u, int wr, int wc, int fr, int fq) const {
        const int pn = u.pn;
        LAS float* ssx = (LAS float*)(ldsb + EPI_SSX_OFF);
        if constexpr (MODE == M_GATES) {
            if (pn < 8) {
                const bf16* Ob = (const bf16*)(pn < 4 ? ob : ws + WS_DV);
#pragma unroll
                for (int ai = 0; ai < 2; ++ai)
#pragma unroll
                    for (int m = 0; m < 4; ++m)
#pragma unroll
                        for (int bj = 0; bj < 2; ++bj) {
                            const int rowl = ai * 128 + wr * 64 + m * 16 + fr, cu = bj * 128 + wc * 32 + 8 * fq;
                            float o[8]; unpack8(*(const v4u*)(Ob + (size_t)(u.pm * 256 + rowl) * 1024 + (pn & 3) * 256 + cu), o);
                            float q = ((o[0] * o[0] + o[1] * o[1]) + (o[2] * o[2] + o[3] * o[3])) + ((o[4] * o[4] + o[5] * o[5]) + (o[6] * o[6] + o[7] * o[7]));
                            q = xsum32(xsum16(q));
                            if (fq == 0) ssx[(rowl * 2 + bj) * 4 + wc] = q;
                        }
                asm volatile("s_waitcnt lgkmcnt(0)" ::: "memory"); __builtin_amdgcn_s_barrier(); asm volatile("" ::: "memory");
            }
        }
#pragma unroll
        for (int ai = 0; ai < 2; ++ai)
#pragma unroll
            for (int m = 0; m < 4; ++m) {
                const int row = u.pm * 256 + ai * 128 + wr * 64 + m * 16 + fr;
#pragma unroll
                for (int bj = 0; bj < 2; ++bj) {
                    const int cu = bj * 128 + wc * 32 + 8 * fq;
                    const pg8::f32x4 v0 = acc[ai][bj][m][0], v1 = acc[ai][bj][m][1];
                    float v[8] = {v0[0], v0[1], v0[2], v0[3], v1[0], v1[1], v1[2], v1[3]};
                    if constexpr (MODE == M_INPROJ) {
                        if (pn < 20) {
                            bf16* base; int ld, col;
                            if (pn < 2) { base = (bf16*)(ws + WS_AQ); ld = 512; col = pn * 256 + cu; }
                            else if (pn < 4) { base = (bf16*)(ws + WS_AK); ld = 512; col = (pn - 2) * 256 + cu; }
                            else { base = (bf16*)(ws + WS_AV + (size_t)((pn - 4) >> 2) * (64 * MiB)); ld = 1024; col = ((pn - 4) & 3) * 256 + cu; }
                            const v4u w = pack8f(v);
                            *(v4u*)(base + (size_t)row * ld + col) = w;
                            if (m == 3) { if (pn >= 8 && fr >= 13) { const int chunk = row >> 6, hr = (row & 63) - 61;
                                *(v4u*)((bf16*)(ws + WS_HALO) + ((size_t)chunk * 3 + hr) * 3072 + (pn - 8) * 256 + cu) = w; } }
                        } else if (bj == 0) { if (wc == 0) { float* sm = (float*)(ws + WS_SM) + (size_t)row * 32 + 8 * fq;
                            *(pg8::f32x4*)sm = v0; *(pg8::f32x4*)(sm + 4) = v1; } }
                    } else if constexpr (MODE == M_GATES) {
                        if (pn < 8) {
                            bf16* O; int col, slot; float invd; const float* ow;
                            if (pn < 4) { O = (bf16*)ob; col = pn * 256 + cu; slot = 8 + pn; invd = 1.f / 256.f; ow = p0 + cu; }
                            else { O = (bf16*)(ws + WS_DV); col = (pn - 4) * 256 + cu; slot = col >> 7; invd = 1.f / 128.f; ow = p1 + (col & 127); }
                            float ssv; { const int rowl = ai * 128 + wr * 64 + m * 16 + fr; (void)slot;
                                const pg8::f32x4 q0 = *(const LAS pg8::f32x4*)(ssx + (rowl * 2 + bj) * 4);
                                ssv = (q0[0] + q0[1]) + (q0[2] + q0[3]);
                                if (pn < 4) { const pg8::f32x4 q1 = *(const LAS pg8::f32x4*)(ssx + (rowl * 2 + (bj ^ 1)) * 4); const float s1_ = (q1[0] + q1[1]) + (q1[2] + q1[3]);
                                    ssv = bj == 0 ? ssv + s1_ : s1_ + ssv; } }
                            const float r = rsqrtf(ssv * invd + EPS);
                            bf16* op = O + (size_t)row * 1024 + col;
                            float o[8]; unpack8(*(const v4u*)op, o);
                            const pg8::f32x4 w0 = *(const pg8::f32x4*)ow, w1 = *(const pg8::f32x4*)(ow + 4);
                            const float wv[8] = {w0[0], w0[1], w0[2], w0[3], w1[0], w1[1], w1[2], w1[3]};
#pragma unroll
                            for (int e = 0; e < 8; ++e) v[e] = o[e] * r * wv[e] * siluf_(v[e]);
                            *(v4u*)op = pack8f(v);
                        } else {
                            bf16* G = (bf16*)(ws + (pn < 12 ? WS_SGA : WS_SGD)); const int col = ((pn - 8) & 3) * 256 + cu;
#pragma unroll
                            for (int e = 0; e < 8; ++e) v[e] = sigmoidf_(v[e]);
                            *(v4u*)(G + (size_t)row * 1024 + col) = pack8f(v);
                        }
                    } else if constexpr (MODE == M_BRA) {
                        const size_t off = (size_t)row * 1024 + pn * 256 + cu;
                        float g[8]; unpack8(*(const v4u*)((const bf16*)(ws + WS_SGA) + off), g);
#pragma unroll
                        for (int e = 0; e < 8; ++e) v[e] = g[e] * v[e];
                        *(v4u*)((bf16*)(ws + WS_YA) + off) = pack8f(v);
                    } else if constexpr (MODE == M_BRD) {
                        const size_t off = (size_t)row * 1024 + pn * 256 + cu;
                        float g[8], mg[8]; unpack8(*(const v4u*)((const bf16*)(ws + WS_SGD) + off), g); unpack8(*(const v4u*)((const bf16*)(ws + WS_YA) + off), mg);
#pragma unroll
                        for (int e = 0; e < 8; ++e) v[e] = DBG_BRD_EXPR;
                        *(v4u*)((bf16*)(ws + WS_MG) + off) = pack8f(v);
                    } else if constexpr (MODE == M_OUT) {
                        *(v4u*)((bf16*)(ws + WS_Z) + (size_t)row * 1024 + pn * 256 + cu) = pack8f(v);
                    } else if constexpr (MODE == M_MLP1) {
#pragma unroll
                        for (int e = 0; e < 8; ++e) { const float t = fmaxf(v[e], 0.f); v[e] = t * t; }
                        *(v4u*)((bf16*)(ws + WS_A1) + (size_t)row * 4096 + pn * 256 + cu) = pack8f(v);
                    } else {
                        *(v4u*)((bf16*)(ws + WS_Y) + (size_t)row * 1024 + pn * 256 + cu) = pack8f(v);
                    }
                }
            }
    }
};
template <int MODE>
__device__ __forceinline__ void run_gemm(LAS uchar* lds, const bf16* A, const bf16* Bt, int N, int K, uchar* ws, const float* p0, const float* p1, uchar* ob = nullptr) {
    pg8::Gemm g{A, Bt, T, N, K}; pg8::StaticOrder S; S.init(T, N, (int)gridDim.x, (int)blockIdx.x);
    Epi<MODE> E{ws, p0, p1, ob, lds};
    pg8::gemm_phase<Epi<MODE>, pg8::StaticOrder, PG8_ALIGN, PG8_SP2>((PG8_LAS unsigned char*)lds, g, S, E);
}

constexpr int LP = 136;
constexpr int PL_Q = 0, PL_K = 17408, PL_V = 34816, PL_W = 52224, PL_AM = 69632, PL_SM = 86016, PL_RAW = 86784, RAWP = 784, PL_CW = 139312, PL_EKL = 145456, PL_XU = 86784;
constexpr float QSCALE = 0.08838834764831845f;

__host__ __device__ constexpr int solve_nld(int i) { return ((i + 1) / 2 + 3) / 4; }
__host__ __device__ constexpr bool solve_group_end(int i) { int cnt = 0; bool end = false; for (int r = 0; r <= i; ++r) { cnt += solve_nld(r); end = (cnt + solve_nld(r + 1) > 12); if (end) cnt = 0; } return end; }
#ifndef DBG_SOLVE_LIM
#define DBG_SOLVE_LIM(x) (x)
#endif
__device__ __forceinline__ uchar* reg_addr(uchar* base, int pitch, int q) { return base + (size_t)(q >> 8) * pitch + (q & 255); }

template <bool GDN>
__device__ __forceinline__ void att_frag(LAS uchar* lds, int wave, int lane, const LAS float* gc, bf16* attdst) {
    const int ntq = wave >> 1, kt2 = wave & 1, c = lane & 15, rq = lane >> 4;
    f32x4 d[2];
#pragma unroll
    for (int hh = 0; hh < 2; ++hh) {
        const int mtk = 2 * kt2 + hh; f32x4 acc = {0.f, 0.f, 0.f, 0.f};
#pragma unroll
        for (int kt = 0; kt < 4; ++kt) {
            const bf16x8 a = *(const LAS bf16x8*)(lds + PL_K + ((16 * mtk + c) * LP + 32 * kt + 8 * rq) * 2);
            const bf16x8 b = *(const LAS bf16x8*)(lds + PL_Q + ((16 * ntq + c) * LP + 32 * kt + 8 * rq) * 2);
            acc = MFMA16(a, b, acc);
        }
        const int i = 16 * ntq + c;
#pragma unroll
        for (int jj = 0; jj < 4; ++jj) { const int jp = 16 * mtk + 4 * rq + jj;
            float val = acc[jj];
            if (GDN) val *= QSCALE * __expf(gc[i] - gc[jp]);
            acc[jj] = (jp <= i) ? val : 0.f; }
        d[hh] = acc;
    }
    *(bf16x8*)(attdst + ((ntq * 2 + kt2) * 64 + lane) * 8) = pack8(d[0], d[1]);
}

__device__ __forceinline__ void gdn_load_raw(const Params& P, int item, v4u (&rawv)[7], float& sm_b, float& sm_a) {
    const int tid = threadIdx.x, lane = tid & 63, wave = tid >> 6;
    const int b = item >> 11, n = (item >> 3) & 255, h = item & 7, t0 = b * SEQ + n * 64;
    const uchar* ws = P.ws; const bf16* halo = (const bf16*)(ws + WS_HALO);
    if (wave == 0) { const float* sm = (const float*)(ws + WS_SM) + (size_t)(t0 + lane) * 32; sm_b = sm[16 + h]; sm_a = sm[24 + h]; }
#pragma unroll
    for (int e = 0; e < 7; ++e) {
        const int p = tid + 512 * e; const int r = p / 48, pc = p - r * 48, z = pc >> 4, gq = pc & 15, ri = r - 3;
        v4u xv = {0u, 0u, 0u, 0u};
        if (p < 67 * 48) {
            if (ri >= 0) xv = *(const v4u*)((const bf16*)(ws + WS_DQ + (size_t)z * (64 * MiB)) + (size_t)(t0 + ri) * 1024 + h * 128 + gq * 8);
            else if (n > 0) xv = *(const v4u*)(halo + ((size_t)(b * NCHK + n - 1) * 3 + r) * 3072 + z * 1024 + h * 128 + gq * 8);
        }
        rawv[e] = xv;
    }
}
__device__ __forceinline__ void prep_gdn(const Params& P, LAS uchar* lds, int item, int next_item, v4u (&rawv)[7], float& sm_b, float& sm_a) {
    const int tid = threadIdx.x, lane = tid & 63, wave = tid >> 6;
    const int b = item >> 11, n = (item >> 3) & 255, h = item & 7;
    const int t0 = b * SEQ + n * 64;
    uchar* ws = P.ws;
    LAS float* beta = (LAS float*)(lds + PL_SM); LAS float* gc = beta + 64; LAS float* eg = beta + 128;
    {
#pragma unroll
        for (int e = 0; e < 7; ++e) { const int p = tid + 512 * e; const int r = p / 48, pc = p - r * 48;
            if (p < 67 * 48) *(LAS v4u*)(lds + PL_RAW + r * RAWP + pc * 16) = rawv[e]; }
        __syncthreads();
        const LAS float* cwl = (const LAS float*)(lds + PL_CW);
#pragma unroll
        for (int e = 0; e < 6; ++e) {
            const int z = e >> 1, i = (tid >> 4) + 32 * (e & 1), gq = tid & 15;
            float y[8] = {0.f, 0.f, 0.f, 0.f, 0.f, 0.f, 0.f, 0.f};
#pragma unroll
            for (int jr = 0; jr < 4; ++jr) {
                const v4u xv = *(const LAS v4u*)(lds + PL_RAW + (i + jr) * RAWP + (z * 16 + gq) * 16);
                float xf[8]; unpack8(xv, xf);
                const f32x4 w0 = *(const LAS f32x4*)(cwl + jr * 384 + z * 128 + gq * 8), w1 = *(const LAS f32x4*)(cwl + jr * 384 + z * 128 + gq * 8 + 4);
                y[0] += w0[0] * xf[0]; y[1] += w0[1] * xf[1]; y[2] += w0[2] * xf[2]; y[3] += w0[3] * xf[3];
                y[4] += w1[0] * xf[4]; y[5] += w1[1] * xf[5]; y[6] += w1[2] * xf[6]; y[7] += w1[3] * xf[7];
            }
            float ssq = 0.f;
#pragma unroll
            for (int k = 0; k < 8; ++k) { y[k] = siluf_(y[k]); ssq += y[k] * y[k]; }
            if (z < 2) {
                ssq = row16_sum(ssq);
                const float r = rsqrtf(ssq + EPS);
#pragma unroll
                for (int k = 0; k < 8; ++k) y[k] *= r;
            }
            v4u o; o.x = pk2(y[0], y[1]); o.y = pk2(y[2], y[3]); o.z = pk2(y[4], y[5]); o.w = pk2(y[6], y[7]);
            *(LAS v4u*)(lds + z * 17408 + (i * LP + gq * 8) * 2) = o;
        }
    }
    if (wave == 0) {
        const float bt = sigmoidf_(sm_b);
        float g = -__expf(P.in[13][h]) * softplusf_(sm_a + P.in[14][h]);
#pragma unroll
        for (int o = 1; o < 64; o <<= 1) { const float t = __shfl_up(g, o); if (lane >= o) g += t; }
        beta[lane] = bt; gc[lane] = g; eg[lane] = __expf(g);
        const float gl = __shfl(g, 63); ((LAS float*)(lds + PL_EKL))[lane] = __expf(gl - g);
    }
    __syncthreads();
    const float glast = gc[63];
    {
        const int c = lane & 15, rq = lane >> 4, mt = wave >> 1;
        LAS float* am = (LAS float*)(lds + PL_AM);
#pragma unroll
        for (int hh = 0; hh < 2; ++hh) {
            const int nt = 2 * (wave & 1) + hh; f32x4 acc = {0.f, 0.f, 0.f, 0.f};
#pragma unroll
            for (int kt = 0; kt < 4; ++kt) {
                const bf16x8 a = *(const LAS bf16x8*)(lds + PL_K + ((16 * mt + c) * LP + 32 * kt + 8 * rq) * 2);
                const bf16x8 bb = *(const LAS bf16x8*)(lds + PL_K + ((16 * nt + c) * LP + 32 * kt + 8 * rq) * 2);
                acc = MFMA16(a, bb, acc);
            }
            const int j = 16 * nt + c;
#pragma unroll
            for (int jj = 0; jj < 4; ++jj) { const int i = 16 * mt + 4 * rq + jj;
                am[i * 64 + (j & 1) * 32 + (j >> 1)] = (j < i) ? beta[i] * acc[jj] * __expf(gc[i] - gc[j]) : 0.f; }
        }
        att_frag<true>(lds, wave, lane, gc, (bf16*)(ws + WS_ATTD) + ((size_t)(b * NCHK + n) * 8 + h) * 4096);
    }
    __syncthreads();
    uchar* rQ = ws + WS_DQ + ((size_t)t0 * 1024 + h * 128) * 2;
    uchar* rK = ws + WS_DK + ((size_t)t0 * 1024 + h * 128) * 2;
    uchar* rU = ws + WS_DV + ((size_t)t0 * 1024 + h * 128) * 2;
    {
        const int cc = wave * 32 + (lane & 31), p = lane >> 5;
        const LAS bf16* colp = (const LAS bf16*)(lds + (cc < 128 ? PL_V : PL_K)) + (cc & 127);
        int vzero; asm volatile("v_mov_b32 %0, 0" : "=v"(vzero));
        const LAS float* betav = beta + vzero; const LAS float* egv = eg + vzero;
        const LAS float* am = (const LAS float*)(lds + PL_AM) + vzero + p * 32;
        float xo[32];
#pragma unroll
        for (int k = 0; k < 32; ++k) xo[k] = 0.f;
        LAS bf16* xt = (LAS bf16*)(lds + (cc < 128 ? PL_XU : PL_W)) + (cc & 127);
        const float sgn = (cc < 128) ? 1.f : -1.f;
#pragma unroll
        for (int i = 0; i < 64; ++i) {
            float rhs = betav[i] * bf2f(colp[i * LP]); if (cc >= 128) rhs *= egv[i];
            float ac[4] = {0.f, 0.f, 0.f, 0.f};
            constexpr int dummy = 0; (void)dummy;
            const int nj = (i + 1) / 2;
#pragma unroll
            for (int j4 = 0; j4 < DBG_SOLVE_LIM((nj + 3) / 4); ++j4) {
                const f32x4 a = *(const LAS f32x4*)(am + i * 64 + 4 * j4);
#pragma unroll
                for (int e = 0; e < 4; ++e) if (4 * j4 + e < nj) ac[e] += a[e] * xo[4 * j4 + e];
            }
            float tot = (ac[0] + ac[1]) + (ac[2] + ac[3]);
            if (i > 0) tot = xsum32(tot);
            const float xi = rhs - tot;
            if (p == (i & 1)) { xo[i >> 1] = xi; xt[i * LP] = (bf16)f2bf(sgn * xi); }
            if (solve_group_end(i)) asm volatile("" ::: "memory");
        }
    }
    __syncthreads();
    if (next_item < 4096) gdn_load_raw(P, next_item, rawv, sm_b, sm_a);
    {
#pragma unroll
        for (int e = 0; e < 2; ++e) {
            const int fl = tid + 512 * e, mt = fl >> 8, kt = (fl >> 6) & 3, r = fl & 15, kq = (fl >> 4) & 3, i = 16 * mt + r;
            const v2u a = *(const LAS v2u*)(lds + PL_Q + (i * LP + 32 * kt + 4 * kq) * 2), bq = *(const LAS v2u*)(lds + PL_Q + (i * LP + 32 * kt + 16 + 4 * kq) * 2);
            const float f = QSCALE * eg[i];
            v4u o; o.x = pk2(bflo(a.x) * f, bfhi(a.x) * f); o.y = pk2(bflo(a.y) * f, bfhi(a.y) * f); o.z = pk2(bflo(bq.x) * f, bfhi(bq.x) * f); o.w = pk2(bflo(bq.y) * f, bfhi(bq.y) * f);
            *(v4u*)reg_addr(rQ, 2048, fl * 16) = o;
        }
#pragma unroll
        for (int e = 0; e < 2; ++e) {
            const int fl = tid + 512 * e, mt8 = fl >> 7, kt2 = (fl >> 6) & 1, r = fl & 15, kq = (fl >> 4) & 3, d = 16 * mt8 + r;
            float vv[8];
#pragma unroll
            for (int s = 0; s < 8; ++s) { const int j = 32 * kt2 + (s < 4 ? 4 * kq + s : 16 + 4 * kq + s - 4);
                vv[s] = bf2f(((const LAS bf16*)(lds + PL_K))[j * LP + d]) * ((const LAS float*)(lds + PL_EKL))[j]; }
            v4u o; o.x = pk2(vv[0], vv[1]); o.y = pk2(vv[2], vv[3]); o.z = pk2(vv[4], vv[5]); o.w = pk2(vv[6], vv[7]);
            *(v4u*)reg_addr(rK, 2048, fl * 16) = o;
        }
        if (tid < 128) ((float*)(ws + WS_DEC))[((size_t)(b * NCHK + n) * 12 + h) * 128 + tid] = __expf(glast);
#pragma unroll
        for (int e = 0; e < 4; ++e) {
            const int it = tid + 512 * e, sl = it >> 8, mt = (it >> 6) & 3, ln = it & 63, c = ln & 15, rq = ln >> 4;
            const LAS bf16* up = (const LAS bf16*)(lds + PL_XU) + (16 * mt + 4 * rq) * LP + sl * 16 + c;
            v2u o; o.x = (unsigned)up[0] | ((unsigned)up[LP] << 16); o.y = (unsigned)up[2 * LP] | ((unsigned)up[3 * LP] << 16);
            { const int q_ = (((sl & 3) * 4 + mt) * 64 + ln) * 8; *(v2u*)(rU + (size_t)(q_ >> 7) * 2048 + (sl >> 2) * 128 + (q_ & 127)) = o; }
        }
        bf16* wdst = (bf16*)((uchar*)P.out + 64 * MiB) + ((size_t)(b * NCHK + n) * 8 + h) * 8192;
#pragma unroll
        for (int e = 0; e < 2; ++e) {
            const int fl = tid + 512 * e, mt = fl >> 8, kt = (fl >> 6) & 3, r = fl & 15, kq = (fl >> 4) & 3, i = 16 * mt + r;
            const v2u a = *(const LAS v2u*)(lds + PL_W + (i * LP + 32 * kt + 4 * kq) * 2), bq = *(const LAS v2u*)(lds + PL_W + (i * LP + 32 * kt + 16 + 4 * kq) * 2);
            v4u o; o.x = a.x; o.y = a.y; o.z = bq.x; o.w = bq.y;
            *(v4u*)(wdst + fl * 8) = o;
        }
    }
    __syncthreads();
}

constexpr int GL_V = 34816, GL_ALR = 68608, GL_BQ = 72704, GL_BL = 74752, VP = 264;
struct GlaRaw { v4u v[4]; f32x4 alr; unsigned short q[16], k[16]; };
__device__ __forceinline__ void gla_load_raw(const Params& P, int item, GlaRaw& R) {
    const int tid = threadIdx.x;
    const int b = item >> 10, n = (item >> 2) & 255, h = item & 3, t0 = b * SEQ + n * 64;
    const uchar* ws = P.ws;
    if (tid < 256) { const int i = tid >> 2, r4 = (tid & 3) * 4; R.alr = *(const f32x4*)((const float*)(ws + WS_SM) + (size_t)(t0 + i) * 32 + r4); }
#pragma unroll
    for (int e = 0; e < 4; ++e) { const int p = tid + 512 * e, i = p >> 5, g8 = p & 31;
        R.v[e] = *(const v4u*)((const bf16*)(ws + WS_AV) + (size_t)(t0 + i) * 1024 + h * 256 + g8 * 8); }
    const int d = tid & 127, qt = tid >> 7;
    const bf16* aq = (const bf16*)(ws + WS_AQ) + (size_t)(t0 + 16 * qt) * 512 + h * 128 + d;
    const bf16* ak = (const bf16*)(ws + WS_AK) + (size_t)(t0 + 16 * qt) * 512 + h * 128 + d;
#pragma unroll
    for (int ii = 0; ii < 16; ++ii) { R.q[ii] = aq[(size_t)ii * 512]; R.k[ii] = ak[(size_t)ii * 512]; }
}
__device__ __forceinline__ void prep_gla(const Params& P, LAS uchar* lds, int item, int next_item, GlaRaw& R, const float (&wl)[16], float bias) {
    const int tid = threadIdx.x, lane = tid & 63, wave = tid >> 6;
    const int b = item >> 10, n = (item >> 2) & 255, h = item & 3;
    const int t0 = b * SEQ + n * 64;
    uchar* ws = P.ws;
    LAS float* alr = (LAS float*)(lds + GL_ALR); LAS float* bqs = (LAS float*)(lds + GL_BQ); LAS float* bl = (LAS float*)(lds + GL_BL);
    if (tid < 256) { const int i = tid >> 2, r4 = (tid & 3) * 4; *(LAS f32x4*)(alr + i * 16 + r4) = R.alr; }
#pragma unroll
    for (int e = 0; e < 4; ++e) { const int p = tid + 512 * e, i = p >> 5, g8 = p & 31; *(LAS v4u*)(lds + GL_V + (i * VP + g8 * 8) * 2) = R.v[e]; }
    __syncthreads();
    const int d = tid & 127, qt = tid >> 7;
    float bloc[16];
    {
        float run = 0.f;
#pragma unroll
        for (int ii = 0; ii < 16; ++ii) { const int i = 16 * qt + ii; float z = bias;
#pragma unroll
            for (int r4 = 0; r4 < 4; ++r4) { const f32x4 a = *(const LAS f32x4*)(alr + i * 16 + 4 * r4);
                z += a[0] * wl[4 * r4] + a[1] * wl[4 * r4 + 1] + a[2] * wl[4 * r4 + 2] + a[3] * wl[4 * r4 + 3]; }
            run += -softplusf_(-z) * (1.f / 16.f); bloc[ii] = run; }
        bqs[qt * 128 + d] = run;
    }
    __syncthreads();
    {
        float off = 0.f, tot = 0.f;
#pragma unroll
        for (int q = 0; q < 4; ++q) { const float t = bqs[q * 128 + d]; if (q < qt) off += t; tot += t; }
#pragma unroll
        for (int ii = 0; ii < 16; ++ii) { const int i = 16 * qt + ii; const float bi = off + bloc[ii];
            const float qv = bf2f(R.q[ii]) * QSCALE * __expf(bi), kv = bf2f(R.k[ii]) * __expf(-bi);
            ((LAS bf16*)(lds + PL_Q))[i * LP + d] = (bf16)f2bf(qv); ((LAS bf16*)(lds + PL_K))[i * LP + d] = (bf16)f2bf(kv); }
        if (qt == 0) { bl[d] = tot; ((float*)(ws + WS_DEC))[((size_t)(b * NCHK + n) * 12 + 8 + h) * 128 + d] = __expf(tot); }
    }
    __syncthreads();
    if (next_item < 2048) gla_load_raw(P, next_item, R);
    att_frag<false>(lds, wave, lane, nullptr, (bf16*)(ws + WS_ATTA) + ((size_t)(b * NCHK + n) * 4 + h) * 4096);
    uchar* rQ = ws + WS_AQ + ((size_t)t0 * 512 + h * 128) * 2;
    uchar* rK = ws + WS_AK + ((size_t)t0 * 512 + h * 128) * 2;
#pragma unroll
    for (int e = 0; e < 2; ++e) {
        const int fl = tid + 512 * e, mt = fl >> 8, kt = (fl >> 6) & 3, r = fl & 15, kq = (fl >> 4) & 3, i = 16 * mt + r;
        const v2u a = *(const LAS v2u*)(lds + PL_Q + (i * LP + 32 * kt + 4 * kq) * 2), bq = *(const LAS v2u*)(lds + PL_Q + (i * LP + 32 * kt + 16 + 4 * kq) * 2);
        v4u o; o.x = a.x; o.y = a.y; o.z = bq.x; o.w = bq.y;
        *(v4u*)reg_addr(rQ, 1024, fl * 16) = o;
    }
#pragma unroll
    for (int e = 0; e < 2; ++e) {
        const int fl = tid + 512 * e, mt8 = fl >> 7, kt2 = (fl >> 6) & 1, r = fl & 15, kq = (fl >> 4) & 3, dd = 16 * mt8 + r;
        const float f = __expf(bl[dd]); float vv[8];
#pragma unroll
        for (int s = 0; s < 8; ++s) { const int j = 32 * kt2 + (s < 4 ? 4 * kq + s : 16 + 4 * kq + s - 4);
            vv[s] = bf2f(((const LAS bf16*)(lds + PL_K))[j * LP + dd]) * f; }
        v4u o; o.x = pk2(vv[0], vv[1]); o.y = pk2(vv[2], vv[3]); o.z = pk2(vv[4], vv[5]); o.w = pk2(vv[6], vv[7]);
        *(v4u*)reg_addr(rK, 1024, fl * 16) = o;
    }
#pragma unroll
    for (int e = 0; e < 8; ++e) {
        const int it = tid + 512 * e, g = it >> 11, sl = (it >> 8) & 7, mt = (it >> 6) & 3, ln = it & 63, c = ln & 15, rq = ln >> 4;
        const LAS bf16* vp = (const LAS bf16*)(lds + GL_V) + (16 * mt + 4 * rq) * VP + g * 128 + sl * 16 + c;
        v2u o; o.x = (unsigned)vp[0] | ((unsigned)vp[VP] << 16); o.y = (unsigned)vp[2 * VP] | ((unsigned)vp[3 * VP] << 16);
        uchar* rU = ws + WS_AV + ((size_t)t0 * 1024 + h * 256 + g * 128) * 2;
        *(v2u*)reg_addr(rU, 2048, ((sl * 4 + mt) * 64 + ln) * 8) = o;
    }
    __syncthreads();
}

constexpr int SC_W = 0, SC_Q = 16384, SC_K = 32768, SC_A = 49152, SC_U = 57344, SC_D = 65536, SC_BUF = 66048;
constexpr int SC_PF_DEPTH = 6;
struct ScStage { v4u w[2], q[2], k[2], u, a, d; };
__device__ __forceinline__ void phase_scan(const Params& P, LAS uchar* lds) {
    const int su = blockIdx.x & 63, pfk = ((int)blockIdx.x >> 6) - 1;
    const int tid = threadIdx.x, lane = tid & 63, s = tid >> 6, c = lane & 15, rq = lane >> 4;
    const bool gdn = su < 32;
    int b, h, g = 0, gh; if (gdn) { gh = su >> 4; b = (su >> 3) & 1; h = su & 7; } else { const int v = su - 32, q = v >> 3; g = q >> 1; gh = q & 1; b = (v >> 2) & 1; h = v & 3; }
    uchar* ws = P.ws;
    const uchar *pW, *pQ, *pK, *pA, *pD, *pU; uchar* pO; size_t sW, sQ, sA; int pitchQ, slot;
    if (gdn) {
        pW = (const uchar*)P.out + 64 * MiB + ((size_t)(b * NCHK) * 8 + h) * 16384; sW = 8 * 16384;
        pQ = ws + WS_DQ + ((size_t)(b * SEQ) * 1024 + h * 128) * 2; pK = ws + WS_DK + ((size_t)(b * SEQ) * 1024 + h * 128) * 2; pitchQ = 2048; sQ = 64 * 2048;
        pU = ws + WS_DV + ((size_t)(b * SEQ) * 1024 + h * 128) * 2;
        pO = ws + WS_DV + ((size_t)(b * SEQ) * 1024 + h * 128) * 2;
        pA = ws + WS_ATTD + ((size_t)(b * NCHK) * 8 + h) * 8192; sA = 8 * 8192; slot = h;
    } else {
        pW = nullptr; sW = 0;
        pQ = ws + WS_AQ + ((size_t)(b * SEQ) * 512 + h * 128) * 2; pK = ws + WS_AK + ((size_t)(b * SEQ) * 512 + h * 128) * 2; pitchQ = 1024; sQ = 64 * 1024;
        pU = ws + WS_AV + ((size_t)(b * SEQ) * 1024 + h * 256 + g * 128) * 2;
        pO = (uchar*)P.out + ((size_t)(b * SEQ) * 1024 + h * 256 + g * 128) * 2;
        pA = ws + WS_ATTA + ((size_t)(b * NCHK) * 4 + h) * 8192; sA = 4 * 8192; slot = 8 + h;
    }
    const size_t sU = 64 * 2048, sD = 12 * 512;
    pD = ws + WS_DEC + ((size_t)(b * NCHK) * 12 + slot) * 512;
    const unsigned ooff = (unsigned)(4 * rq * 1024 + gh * 64 + 16 * (s & 3) + c);
    unsigned* prog = (unsigned*)(ws + WS_PROG) + su * 64;
    if (pfk >= 0) {
        const int npf = ((int)gridDim.x >> 6) - 1;
        for (int n = pfk; n < NCHK; n += npf) {
            if (n > SC_PF_DEPTH) { int spins = 0;
                while ((int)__hip_atomic_load(prog, __ATOMIC_RELAXED, __HIP_MEMORY_SCOPE_AGENT) < n - SC_PF_DEPTH && ++spins < (1 << 18)) __builtin_amdgcn_s_sleep(8); }
            const uchar* a0; const int q = tid & 127;
            if (tid < 128) a0 = gdn ? pW + (size_t)n * sW + q * 128 : pA + (size_t)n * sA + (q & 63) * 128;
            else if (tid < 256) a0 = pQ + (size_t)n * sQ + (size_t)(q >> 1) * pitchQ + (q & 1) * 128;
            else if (tid < 384) a0 = pK + (size_t)n * sQ + (size_t)(q >> 1) * pitchQ + (q & 1) * 128;
            else a0 = gdn ? pU + (size_t)n * sU + (size_t)(q & 63) * 2048 + gh * 128 : pU + (size_t)n * sU + (size_t)(gh * 32 + ((q & 63) >> 1)) * 2048 + (q & 1) * 128;
            (void)*(const volatile unsigned*)a0;
            if (tid < 64) (void)*(const volatile unsigned*)(pA + (size_t)n * sA + tid * 128);
            else if (tid < 68) (void)*(const volatile unsigned*)(pD + (size_t)n * sD + (tid - 64) * 128);
        }
        return;
    }
    const v4u z4 = {0u, 0u, 0u, 0u};
#define SC_LOAD(R, n) do { \
        if (gdn) { R.w[0] = *(const v4u*)(pW + (size_t)(n) * sW + tid * 16); R.w[1] = *(const v4u*)(pW + (size_t)(n) * sW + (tid + 512) * 16); } \
        _Pragma("unroll") for (int e_ = 0; e_ < 2; ++e_) { const int i_ = tid + 512 * e_; \
            R.q[e_] = *(const v4u*)(pQ + (size_t)(n) * sQ + (size_t)(i_ >> 4) * pitchQ + (i_ & 15) * 16); \
            R.k[e_] = *(const v4u*)(pK + (size_t)(n) * sQ + (size_t)(i_ >> 4) * pitchQ + (i_ & 15) * 16); \
        } \
        R.u = *(const v4u*)(pU + (size_t)(n) * sU + (size_t)(gh * 32 + (tid >> 4)) * 2048 + (tid & 15) * 16); \
        R.a = *(const v4u*)(pA + (size_t)(n) * sA + tid * 16); \
        if (tid < 32) R.d = *(const v4u*)(pD + (size_t)(n) * sD + tid * 16); \
    } while (0)
#define SC_STORE(R, buf) do { LAS uchar* l_ = lds + (buf) * SC_BUF; \
        *(LAS v4u*)(l_ + SC_W + tid * 16) = R.w[0]; *(LAS v4u*)(l_ + SC_W + (tid + 512) * 16) = R.w[1]; \
        *(LAS v4u*)(l_ + SC_Q + tid * 16) = R.q[0]; *(LAS v4u*)(l_ + SC_Q + (tid + 512) * 16) = R.q[1]; \
        *(LAS v4u*)(l_ + SC_K + tid * 16) = R.k[0]; *(LAS v4u*)(l_ + SC_K + (tid + 512) * 16) = R.k[1]; \
        *(LAS v4u*)(l_ + SC_U + tid * 16) = R.u; \
        *(LAS v4u*)(l_ + SC_A + tid * 16) = R.a; \
        if (tid < 32) *(LAS v4u*)(l_ + SC_D + tid * 16) = R.d; \
    } while (0)
    f32x4 S[8];
#pragma unroll
    for (int i = 0; i < 8; ++i) S[i] = (f32x4){0.f, 0.f, 0.f, 0.f};
#define LDF(dst, off, i0) do { _Pragma("unroll") for (int i_ = 0; i_ < 8; ++i_) dst[i_] = *(const LAS bf16x8*)(L + (off) + (((i0) + i_) * 64 + lane) * 16); } while (0)
#define SC_STEP(n, buf) do { \
        const LAS uchar* L = lds + (buf) * SC_BUF; \
        bf16x8 fa[8], fb[8]; \
        v2u uu[4]; \
        _Pragma("unroll") for (int mt = 0; mt < 4; ++mt) uu[mt] = *(const LAS v2u*)(L + SC_U + (((s & 3) * 4 + mt) * 64 + lane) * 8); \
        if (gdn) { LDF(fa, SC_W, 0); LDF(fb, SC_W, 8); } else { LDF(fa, SC_Q, 0); LDF(fb, SC_Q, 8); } \
        bf16x8 Sb[4]; \
        _Pragma("unroll") for (int kt = 0; kt < 4; ++kt) Sb[kt] = pack8(S[2 * kt], S[2 * kt + 1]); \
        f32x4 vn[4]; \
        _Pragma("unroll") for (int mt = 0; mt < 4; ++mt) vn[mt] = (f32x4){bflo(uu[mt].x), bfhi(uu[mt].x), bflo(uu[mt].y), bfhi(uu[mt].y)}; \
        if (gdn) { \
            _Pragma("unroll") for (int mt = 0; mt < 2; ++mt) _Pragma("unroll") for (int kt = 0; kt < 4; ++kt) vn[mt] = MFMA16(fa[mt * 4 + kt], Sb[kt], vn[mt]); \
            LDF(fa, SC_Q, 0); \
            _Pragma("unroll") for (int mt = 0; mt < 2; ++mt) _Pragma("unroll") for (int kt = 0; kt < 4; ++kt) vn[2 + mt] = MFMA16(fb[mt * 4 + kt], Sb[kt], vn[2 + mt]); \
            LDF(fb, SC_Q, 8); \
        } \
        f32x4 o[4]; \
        _Pragma("unroll") for (int mt = 0; mt < 4; ++mt) o[mt] = (f32x4){0.f, 0.f, 0.f, 0.f}; \
        _Pragma("unroll") for (int mt = 0; mt < 2; ++mt) _Pragma("unroll") for (int kt = 0; kt < 4; ++kt) o[mt] = MFMA16(fa[mt * 4 + kt], Sb[kt], o[mt]); \
        LDF(fa, SC_A, 0); \
        _Pragma("unroll") for (int mt = 0; mt < 2; ++mt) _Pragma("unroll") for (int kt = 0; kt < 4; ++kt) o[2 + mt] = MFMA16(fb[mt * 4 + kt], Sb[kt], o[2 + mt]); \
        LDF(fb, SC_K, 0); \
        bf16x8 vb[2]; vb[0] = pack8(vn[0], vn[1]); vb[1] = pack8(vn[2], vn[3]); \
        f32x4 dvv[8]; \
        _Pragma("unroll") for (int m8 = 0; m8 < 8; ++m8) dvv[m8] = *(const LAS f32x4*)(L + SC_D + (16 * m8 + 4 * rq) * 4); \
        _Pragma("unroll") for (int mt = 0; mt < 4; ++mt) _Pragma("unroll") for (int k2 = 0; k2 < 2; ++k2) o[mt] = MFMA16(fa[mt * 2 + k2], vb[k2], o[mt]); \
        LDF(fa, SC_K, 8); \
        _Pragma("unroll") for (int m8 = 0; m8 < 4; ++m8) { f32x4 acc = S[m8] * dvv[m8]; \
            _Pragma("unroll") for (int k2 = 0; k2 < 2; ++k2) acc = MFMA16(fb[m8 * 2 + k2], vb[k2], acc); \
            S[m8] = acc; } \
        _Pragma("unroll") for (int m8 = 0; m8 < 4; ++m8) { f32x4 acc = S[4 + m8] * dvv[4 + m8]; \
            _Pragma("unroll") for (int k2 = 0; k2 < 2; ++k2) acc = MFMA16(fa[m8 * 2 + k2], vb[k2], acc); \
            S[4 + m8] = acc; } \
        { bf16* ob = (bf16*)(pO + (size_t)(n) * sU) + ooff; \
          _Pragma("unroll") for (int mt = 0; mt < 4; ++mt) { const unsigned p01 = pk2(o[mt][0], o[mt][1]), p23 = pk2(o[mt][2], o[mt][3]); \
                ob[(16 * mt + 0) * 1024] = (bf16)p01; ob[(16 * mt + 1) * 1024] = (bf16)(p01 >> 16); ob[(16 * mt + 2) * 1024] = (bf16)p23; ob[(16 * mt + 3) * 1024] = (bf16)(p23 >> 16); } } \
    } while (0)

#define SC_DMA(n, buf) do { \
        LAS uchar* l_ = lds + (buf) * SC_BUF + dma_l0; const uchar* g_ = dma_g0 + (size_t)(n) * dma_sn; \
        if (dma_on) { \
            _Pragma("unroll 1") for (int j_ = 0; j_ < 8; ++j_) { __builtin_amdgcn_global_load_lds((const unsigned*)g_, (LAS unsigned*)l_, 16, 0, 0); g_ += dma_sj; l_ += 1024; } \
            const uchar* g2_ = dma_g1 + (size_t)(n) * dma_sn1; \
            _Pragma("unroll 1") for (int j_ = 0; j_ < 8; ++j_) { __builtin_amdgcn_global_load_lds((const unsigned*)g2_, (LAS unsigned*)l_, 16, 0, 0); g2_ += dma_sj1; l_ += 1024; } \
            if (s == 7 && lane < 32) __builtin_amdgcn_global_load_lds((const unsigned*)(pD + (size_t)(n) * sD + lane * 16), (LAS unsigned*)(lds + (buf) * SC_BUF + SC_D), 16, 0, 0); \
        } \
    } while (0)
    const uchar *dma_g0 = nullptr, *dma_g1 = nullptr; size_t dma_sn = 0, dma_sn1 = 0; int dma_sj = 0, dma_sj1 = 0, dma_l0 = 0; bool dma_on = false;
    if (s == 4) { dma_on = gdn; dma_g0 = pW + lane * 16; dma_sn = sW; dma_sj = 1024; dma_g1 = dma_g0 + 8192; dma_sn1 = sW; dma_sj1 = 1024; dma_l0 = SC_W; }
    else if (s == 5 || s == 6) { const uchar* bs = (s == 5 ? pQ : pK) + (size_t)(lane >> 4) * pitchQ + (lane & 15) * 16;
        dma_on = true; dma_g0 = bs; dma_sn = sQ; dma_sj = 4 * pitchQ; dma_g1 = bs + (size_t)32 * pitchQ; dma_sn1 = sQ; dma_sj1 = 4 * pitchQ; dma_l0 = (s == 5 ? SC_Q : SC_K); }
    else if (s == 7) { dma_on = true; dma_g0 = pA + lane * 16; dma_sn = sA; dma_sj = 1024;
        if (gdn) { dma_g1 = pU + (size_t)(lane >> 3) * 2048 + gh * 128 + (lane & 7) * 16; dma_sj1 = 8 * 2048; }
        else { dma_g1 = pU + (size_t)(gh * 32 + (lane >> 4)) * 2048 + (lane & 15) * 16; dma_sj1 = 4 * 2048; }
        dma_sn1 = sU; dma_l0 = SC_A; }
    if (s >= 4) { SC_DMA(0, 0); asm volatile("s_waitcnt vmcnt(0)" ::: "memory"); }
    else if (!gdn) { const v4u zz = {0u, 0u, 0u, 0u}; for (int i = tid; i < 1024; i += 256) { *(LAS v4u*)(lds + SC_W + i * 16) = zz; *(LAS v4u*)(lds + SC_BUF + SC_W + i * 16) = zz; } }
    __syncthreads();
    for (int n = 0; n < NCHK; n += 2) {
        if (tid == 0) __hip_atomic_store(prog, (unsigned)n, __ATOMIC_RELAXED, __HIP_MEMORY_SCOPE_AGENT);
        if (s < 4) SC_STEP(n, 0); else { SC_DMA(n + 1, 1); asm volatile("s_waitcnt vmcnt(0)" ::: "memory"); }
        __syncthreads();
        if (s < 4) SC_STEP(n + 1, 1); else { if (n + 2 < NCHK) SC_DMA(n + 2, 0); asm volatile("s_waitcnt vmcnt(0)" ::: "memory"); }
        __syncthreads();
    }
#undef SC_DMA
#undef LDF
#undef SC_LOAD
#undef SC_STORE
#undef SC_STEP
}

#ifndef DBG_BRD_A
#define DBG_BRD_A 0
#endif
#ifndef DBG_BRD_B
#define DBG_BRD_B WS_WBD
#endif
#ifndef PREP_MASK
#define PREP_MASK 3
#endif
__device__ __forceinline__ void phase_prep(const Params& P, LAS uchar* lds) {
        if (PREP_MASK & 2) { int hcur = -1; bool first_ = true; GlaRaw R; float wl[16], bias = 0.f;
            for (int it = blockIdx.x; it < 2048; it += gridDim.x) {
                if ((it & 3) != hcur) { hcur = it & 3; const float* wlr = P.in[9] + hcur * 128 + (threadIdx.x & 127);
#pragma unroll
                    for (int r = 0; r < 16; ++r) wl[r] = wlr[r * 512];
                    bias = P.in[10][hcur * 128 + (threadIdx.x & 127)]; }
                if (first_) { gla_load_raw(P, it, R); first_ = false; }
                prep_gla(P, lds, it, it + (int)gridDim.x, R, wl, bias); } }
        if (PREP_MASK & 1) { int hcur = -1; bool first_ = true; v4u rawv[7]; float sm_b = 0.f, sm_a = 0.f;
            for (int it = blockIdx.x; it < 4096; it += gridDim.x) {
                if ((it & 7) != hcur) { hcur = it & 7; __syncthreads();
                    for (int i = threadIdx.x; i < 1536; i += 512) { const int jr = i / 384, rr = i - jr * 384;
                        ((LAS float*)(lds + PL_CW))[i] = P.in[12][jr * 3072 + (rr >> 7) * 1024 + hcur * 128 + (rr & 127)]; }
                    __syncthreads(); }
                if (first_) { gdn_load_raw(P, it, rawv, sm_b, sm_a); first_ = false; }
                prep_gdn(P, lds, it, it + (int)gridDim.x, rawv, sm_b, sm_a); } }
}
__global__ void __launch_bounds__(512, 2) mega_fwd(Params P) {
    extern __shared__ __attribute__((aligned(16))) unsigned char shm[];
    LAS uchar* lds = (LAS uchar*)shm;
    cg::grid_group grid = cg::this_grid();
    uchar* ws = P.ws;
    const int lo = P.lo, hi = P.hi;
#ifndef PH_MASK
#define PH_MASK 0x3fff
#endif
#define IN(k) (((PH_MASK >> (k)) & 1) && lo <= (k) && (k) < hi)
#ifndef REP_MASK
#define REP_MASK 0
#endif
#define REP(k) ((REP_MASK >> (k)) & 1)
#define SEAM(k) do { if (IN(k) && IN((k) + 1)) grid.sync(); } while (0)
#ifndef DBG_Q
#define DBG_Q 10.0f
#endif
#ifdef DBG_T
    unsigned long long ta0 = __builtin_amdgcn_s_memrealtime(), ta1 = 0;
#endif
    if (IN(0)) { phase0<false, true>(P, lds); } SEAM(0);
#ifdef DBG_T
    if (DBG_T == 100) ta1 = __builtin_amdgcn_s_memrealtime();
#endif
    if (IN(1)) { phase_norm1<false>(P); phase0<true, false>(P, lds); } SEAM(1);
    if (IN(2)) { run_gemm<M_INPROJ>(lds, (const bf16*)(ws + WS_HB), (const bf16*)(ws + WS_WIN), WIN1_ROWS, 1024, ws, nullptr, nullptr); if (REP(2)) { grid.sync(); run_gemm<M_INPROJ>(lds, (const bf16*)(ws + WS_HB), (const bf16*)(ws + WS_WIN), WIN1_ROWS, 1024, ws, nullptr, nullptr); } } SEAM(2);
    unsigned long long tt0 = 0, tt1 = 0;
#ifdef DBG_T
    if (DBG_T == 3) tt0 = __builtin_amdgcn_s_memrealtime();
#endif
    if (IN(3)) { phase_prep(P, lds); if (REP(3)) { grid.sync(); run_gemm<M_INPROJ>(lds, (const bf16*)(ws + WS_HB), (const bf16*)(ws + WS_WIN), WIN1_ROWS, 1024, ws, nullptr, nullptr); grid.sync(); phase_prep(P, lds); }
    } SEAM(3);
#ifdef DBG_T
    if (DBG_T == 3) tt1 = __builtin_amdgcn_s_memrealtime();
    if (DBG_T == 4) tt0 = __builtin_amdgcn_s_memrealtime();
#endif
    if (IN(4)) { phase_scan(P, lds); if (REP(4)) { grid.sync(); phase_scan(P, lds); } } SEAM(4);
#ifdef DBG_T
    if (DBG_T == 4) tt1 = __builtin_amdgcn_s_memrealtime();
#endif
    if (IN(6)) { run_gemm<M_GATES>(lds, (const bf16*)(ws + WS_HB), (const bf16*)(ws + WS_WIN) + (size_t)WIN1_ROWS * 1024, WIN2_ROWS, 1024, ws, P.in[11], P.in[15], (uchar*)P.out); if (REP(6)) { grid.sync(); run_gemm<M_GATES>(lds, (const bf16*)(ws + WS_HB), (const bf16*)(ws + WS_WIN) + (size_t)WIN1_ROWS * 1024, WIN2_ROWS, 1024, ws, P.in[11], P.in[15], (uchar*)P.out); } } SEAM(6);
    if (IN(7)) { run_gemm<M_BRA>(lds, (const bf16*)P.out, (const bf16*)(ws + WS_WBG), 1024, 1024, ws, nullptr, nullptr); if (REP(7)) { grid.sync(); run_gemm<M_BRA>(lds, (const bf16*)P.out, (const bf16*)(ws + WS_WBG), 1024, 1024, ws, nullptr, nullptr); } }   __syncthreads();
    if (IN(8)) { run_gemm<M_BRD>(lds, (const bf16*)(ws + WS_DV), (const bf16*)(ws + DBG_BRD_B), 1024, 1024, ws, nullptr, nullptr); if (REP(8)) { grid.sync(); run_gemm<M_BRD>(lds, (const bf16*)(ws + WS_DV), (const bf16*)(ws + DBG_BRD_B), 1024, 1024, ws, nullptr, nullptr); } } SEAM(8);
    if (IN(9)) { run_gemm<M_OUT>(lds, (const bf16*)(ws + WS_MG), (const bf16*)(ws + WS_WOUT), 1024, 1024, ws, nullptr, nullptr); if (REP(9)) { grid.sync(); run_gemm<M_OUT>(lds, (const bf16*)(ws + WS_MG), (const bf16*)(ws + WS_WOUT), 1024, 1024, ws, nullptr, nullptr); } } SEAM(9);
    if (IN(10)) { phase_row1(P); if (REP(10)) { grid.sync(); phase_row1(P); } } SEAM(10);
    if (IN(11)) { run_gemm<M_MLP1>(lds, (const bf16*)(ws + WS_H2), (const bf16*)(ws + WS_W1), 4096, 1024, ws, nullptr, nullptr); if (REP(11)) { grid.sync(); run_gemm<M_MLP1>(lds, (const bf16*)(ws + WS_H2), (const bf16*)(ws + WS_W1), 4096, 1024, ws, nullptr, nullptr); } } SEAM(11);
    if (IN(12)) { run_gemm<M_MLP2>(lds, (const bf16*)(ws + WS_A1), (const bf16*)(ws + WS_W2), 1024, 4096, ws, nullptr, nullptr); if (REP(12)) { grid.sync(); run_gemm<M_MLP2>(lds, (const bf16*)(ws + WS_A1), (const bf16*)(ws + WS_W2), 1024, 4096, ws, nullptr, nullptr); } } SEAM(12);
    if (IN(13)) { phase_row2(P); }
#ifdef DBG_T
    if (DBG_T == 0) { tt1 = __builtin_amdgcn_s_memrealtime(); }
    if (DBG_T == 100) { tt0 = ta0; tt1 = ta1; }
    if (DBG_T == 200) { grid.sync(); tt0 = __builtin_amdgcn_s_memrealtime(); for (int q_ = 0; q_ < 16; ++q_) grid.sync(); tt1 = __builtin_amdgcn_s_memrealtime(); }
    grid.sync(); for (size_t i = (size_t)blockIdx.x * 512 + threadIdx.x; i < (size_t)T * 1024; i += (size_t)gridDim.x * 512) P.out[i] = P.in[0][i];
    grid.sync(); if (blockIdx.x == DBG_TB && threadIdx.x == 0) P.out[0] += floorf((float)(tt1 - tt0) * 0.01f / DBG_Q + 0.5f) * DBG_Q;
#endif
#undef IN
#undef SEAM
}

#ifdef DBG_STOP
__global__ void __launch_bounds__(256) dbg_dump(const bf16* src, float* out) {
    for (size_t i = (size_t)blockIdx.x * 256 + threadIdx.x; i < (size_t)T * 1024; i += (size_t)gridDim.x * 256) { unsigned hsh = ((unsigned)src[i] + 1u) * 2654435761u; hsh ^= hsh >> 15; hsh *= 2246822519u; out[i] = (float)(hsh >> 8) * (1.0f / 16777216.0f); }
}
#endif
#ifndef N_LAUNCH_MODE
#define N_LAUNCH_MODE 1
#endif
extern "C" void kernel_launch(void* const* d_in, const int* in_sizes, int n_in, void* d_out, int out_size, void* d_ws, size_t ws_size, hipStream_t stream) {
    static int grid_blocks = 0;
    if (!grid_blocks) {
        int dev = 0, cus = 0, per_cu = 0;
        hipGetDevice(&dev);
        hipDeviceGetAttribute(&cus, hipDeviceAttributeMultiprocessorCount, dev);
        hipFuncSetAttribute((const void*)mega_fwd, hipFuncAttributeMaxDynamicSharedMemorySize, LDS_BYTES);
        hipOccupancyMaxActiveBlocksPerMultiprocessor(&per_cu, (const void*)mega_fwd, 512, LDS_BYTES);
        if (per_cu < 1) { fprintf(stderr, "kernel_launch: occupancy query gives %d blocks per CU\n", per_cu); per_cu = 1; }
        grid_blocks = cus * per_cu;
        if (grid_blocks > 256) grid_blocks = 256;
        if (n_in != 21 || ws_size < WS_END) fprintf(stderr, "kernel_launch: unexpected n_in %d or ws_size %zu (< %zu)\n", n_in, ws_size, (size_t)WS_END);
    }
    Params p{};
    for (int i = 0; i < 21; ++i) p.in[i] = (const float*)d_in[i];
    p.out = (float*)d_out; p.ws = (uchar*)d_ws;
    if (N_LAUNCH_MODE == 1) {
        p.lo = 0; p.hi = NPHASE;
        void* args[] = {&p};
        hipError_t e = hipLaunchCooperativeKernel((const void*)mega_fwd, dim3(grid_blocks), dim3(512), args, LDS_BYTES, stream);
        if (e != hipSuccess) fprintf(stderr, "cooperative launch failed: %s (grid %d)\n", hipGetErrorString(e), grid_blocks);
    } else {
#ifdef DBG_STOP
        for (int k = 0; k <= DBG_STOP; ++k) { p.lo = k; p.hi = k + 1; hipLaunchKernelGGL(mega_fwd, dim3(grid_blocks), dim3(512), LDS_BYTES, stream, p); }
        hipLaunchKernelGGL(dbg_dump, dim3(2048), dim3(256), 0, stream, (const bf16*)((uchar*)d_ws + (size_t)DBG_SRC * MiB), (float*)d_out);
#else
        for (int k = 0; k < NPHASE; ++k) { p.lo = k; p.hi = k + 1; hipLaunchKernelGGL(mega_fwd, dim3(grid_blocks), dim3(512), LDS_BYTES, stream, p); }
#endif
    }
}
```
